# Optimizing an MI355X kernel written in HIP

```python
import math
import jax, jax.numpy as jnp
from jax import lax
import numpy as np

D_MODEL = 1024
BATCH = 8
SEQ = 4096
DEPTH = 2
DEC_BATCH = 128
DEC_SEQ = 8
PAST_LEN = 16384
PAGE_SIZE = 128

N_MIXERS = 2
N_SSM_LAYERS = (DEPTH + 1) // 2
N_SWA_LAYERS = DEPTH // 2

SSM_EXPAND = 2
SSM_D_INNER = SSM_EXPAND * D_MODEL
SSM_HEAD_DIM = 64
SSM_HEADS = SSM_D_INNER // SSM_HEAD_DIM
SSM_GROUPS = 4
SSM_HPG = SSM_HEADS // SSM_GROUPS
SSM_STATE = 128
SSM_CONV = 4
SSM_CHUNK = 128
SSM_CONV_DIM = SSM_D_INNER + 2 * SSM_GROUPS * SSM_STATE
SSM_IN_DIM = SSM_D_INNER + SSM_CONV_DIM + SSM_HEADS

ATTN_HEAD_DIM = 64
ATTN_HEADS = D_MODEL // ATTN_HEAD_DIM
ATTN_KV_HEADS = 4
ATTN_REP = ATTN_HEADS // ATTN_KV_HEADS
WINDOW = 128
SWA_BLOCK = WINDOW
QKV_DIM = (ATTN_HEADS + 2 * ATTN_KV_HEADS) * ATTN_HEAD_DIM

REL_BUCKETS = 32
REL_MAX_DIST = WINDOW

D_FF = 2816
FFN_RES = 0.5
N_SUB = 3
RMS_EPS = 1e-6

kernel_name = 'hybrid_ssd_swa_macaron_step'


def rms_norm(x, g):
    xf = x.astype(jnp.float32)
    y = xf * lax.rsqrt(jnp.mean(xf * xf, axis=-1, keepdims=True) + RMS_EPS)
    return (y * g.astype(jnp.float32)).astype(x.dtype)


def modulated_norm(x, g, m):
    return rms_norm(x, g) * (1 + m[:, :, 1]) + m[:, :, 0]


def swiglu(h, w_in, w_out):
    g, u = jnp.split(h @ w_in, 2, axis=-1)
    return (jax.nn.silu(g) * u) @ w_out


def t5_bucket(dist):
    exact = REL_BUCKETS // 2
    d = jnp.maximum(dist, 0)
    df = jnp.maximum(d, 1).astype(jnp.float32)
    large = exact + (jnp.log(df / exact) / math.log(REL_MAX_DIST / exact) * (REL_BUCKETS - exact)).astype(jnp.int32)
    large = jnp.minimum(large, REL_BUCKETS - 1)
    return jnp.where(d < exact, d, large)


def causal_dwconv(xpad, w, b, l):
    return sum(xpad[:, k:k + l] * w[k] for k in range(SSM_CONV)) + b


def ssd_scan(xdt, dA, Bm, Cm, h0):
    bsz, l = xdt.shape[:2]
    q = min(SSM_CHUNK, l)
    nc = -(-l // q)
    pad = nc * q - l
    if pad:
        padw = lambda a: jnp.pad(a, [(0, 0), (0, pad)] + [(0, 0)] * (a.ndim - 2))
        xdt, dA, Bm, Cm = padw(xdt), padw(dA), padw(Bm), padw(Cm)
    xc = xdt.reshape(bsz, nc, q, SSM_GROUPS, SSM_HPG, SSM_HEAD_DIM)
    Bc = Bm.reshape(bsz, nc, q, SSM_GROUPS, SSM_STATE)
    Cc = Cm.reshape(bsz, nc, q, SSM_GROUPS, SSM_STATE)
    a_cs = jnp.cumsum(dA.reshape(bsz, nc, q, SSM_GROUPS, SSM_HPG), axis=2)
    causal = jnp.tril(jnp.ones((q, q), bool))[None, None, :, :, None, None]
    seg = a_cs[:, :, :, None] - a_cs[:, :, None]
    decay = jnp.exp(jnp.where(causal, seg, -jnp.inf))
    cb = jnp.einsum('bclgn,bcsgn->bclsg', Cc, Bc)
    w = (decay * cb[..., None]).astype(xc.dtype)
    y_diag = jnp.einsum('bclsgr,bcsgrp->bclgrp', w, xc)
    decay_to_end = jnp.exp(a_cs[:, :, -1:] - a_cs)
    chunk_states = jnp.einsum('bclgn,bclgrp->bcgrpn', Bc, xc * decay_to_end[..., None])
    chunk_decay = jnp.exp(a_cs[:, :, -1])

    def step(hc, inp):
        s, a = inp
        return hc * a[..., None, None] + s, hc

    h_T, h_in = lax.scan(step, h0.astype(jnp.float32),
                         (jnp.moveaxis(chunk_states, 1, 0).astype(jnp.float32), jnp.moveaxis(chunk_decay, 1, 0)))
    y_off = jnp.einsum('bclgn,cbgrpn->bclgrp', Cc, h_in) * jnp.exp(a_cs)[..., None]
    y = (y_diag + y_off).reshape(bsz, nc * q, SSM_GROUPS, SSM_HPG, SSM_HEAD_DIM)[:, :l]
    return y.astype(xdt.dtype), h_T


def ssd_mixer(h, conv_buf, h0, in_w, conv_w, conv_b, dt_bias, a_log, d_skip, norm_w, out_w):
    bsz, l, _ = h.shape
    zxbcdt = h @ in_w
    z = zxbcdt[..., :SSM_D_INNER]
    xbc = zxbcdt[..., SSM_D_INNER:SSM_D_INNER + SSM_CONV_DIM]
    dt = zxbcdt[..., SSM_D_INNER + SSM_CONV_DIM:]
    xpad = jnp.concatenate([conv_buf.astype(xbc.dtype), xbc], axis=1)
    new_conv = xpad[:, -(SSM_CONV - 1):]
    xbc = jax.nn.silu(causal_dwconv(xpad, conv_w, conv_b, l))
    gn = SSM_GROUPS * SSM_STATE
    xs = xbc[..., :SSM_D_INNER].reshape(bsz, l, SSM_GROUPS, SSM_HPG, SSM_HEAD_DIM)
    Bm = xbc[..., SSM_D_INNER:SSM_D_INNER + gn].reshape(bsz, l, SSM_GROUPS, SSM_STATE)
    Cm = xbc[..., SSM_D_INNER + gn:].reshape(bsz, l, SSM_GROUPS, SSM_STATE)
    dt = jax.nn.softplus((dt + dt_bias).astype(jnp.float32)).reshape(bsz, l, SSM_GROUPS, SSM_HPG)
    A = -jnp.exp(a_log.astype(jnp.float32)).reshape(SSM_GROUPS, SSM_HPG)
    xdt = xs * dt[..., None].astype(xs.dtype)
    y, h_T = ssd_scan(xdt, dt * A, Bm, Cm, h0.reshape(bsz, SSM_GROUPS, SSM_HPG, SSM_HEAD_DIM, SSM_STATE))
    y = y + xs * d_skip.reshape(SSM_GROUPS, SSM_HPG, 1)
    yg = (y.reshape(bsz, l, SSM_D_INNER) * jax.nn.silu(z)).astype(jnp.float32).reshape(bsz, l, SSM_GROUPS, -1)
    yg = yg * lax.rsqrt(jnp.mean(yg * yg, axis=-1, keepdims=True) + RMS_EPS)
    yn = (yg.reshape(bsz, l, SSM_D_INNER) * norm_w.astype(jnp.float32)).astype(h.dtype)
    new_h = h_T.reshape(bsz, SSM_HEADS, SSM_HEAD_DIM, SSM_STATE).astype(h.dtype)
    return yn @ out_w, new_conv, new_h


def window_attention(q, k, v, q_pos, k_pos, sinks, rel_bias):
    logits = jnp.einsum('...qhrd,...khd->...hrqk', q, k).astype(jnp.float32) * (ATTN_HEAD_DIM ** -0.5)
    dist = q_pos[..., :, None] - k_pos[..., None, :]
    valid = (dist >= 0) & (dist <= WINDOW) & (k_pos[..., None, :] >= 0)
    bias = rel_bias[t5_bucket(dist)].astype(jnp.float32)
    bias = jnp.moveaxis(bias.reshape(bias.shape[:-1] + (ATTN_KV_HEADS, ATTN_REP)), (-2, -1), (-4, -3))
    logits = jnp.where(valid[..., None, None, :, :], logits + bias, -jnp.inf)
    s = sinks.astype(jnp.float32).reshape(ATTN_KV_HEADS, ATTN_REP, 1, 1)
    m = jnp.maximum(jnp.max(logits, axis=-1, keepdims=True), s)
    e = jnp.exp(logits - m)
    p = e / (jnp.sum(e, axis=-1, keepdims=True) + jnp.exp(s - m))
    return jnp.einsum('...hrqk,...khd->...qhrd', p.astype(v.dtype), v)


def swa_mixer(h, k_buf, v_buf, start, qkv_w, qkv_b, sinks, o_w, o_b, rel_bias):
    bsz, l, _ = h.shape
    qkv = h @ qkv_w + qkv_b
    nq = ATTN_HEADS * ATTN_HEAD_DIM
    nkv = ATTN_KV_HEADS * ATTN_HEAD_DIM
    q = qkv[..., :nq].reshape(bsz, l, ATTN_KV_HEADS, ATTN_REP, ATTN_HEAD_DIM)
    k = qkv[..., nq:nq + nkv].reshape(bsz, l, ATTN_KV_HEADS, ATTN_HEAD_DIM)
    v = qkv[..., nq + nkv:].reshape(bsz, l, ATTN_KV_HEADS, ATTN_HEAD_DIM)
    if k_buf is None:
        nb = l // SWA_BLOCK
        qb = q.reshape(bsz, nb, SWA_BLOCK, ATTN_KV_HEADS, ATTN_REP, ATTN_HEAD_DIM)
        kb = k.reshape(bsz, nb, SWA_BLOCK, ATTN_KV_HEADS, ATTN_HEAD_DIM)
        vb = v.reshape(bsz, nb, SWA_BLOCK, ATTN_KV_HEADS, ATTN_HEAD_DIM)
        zk = jnp.zeros_like(kb[:, :1])
        kk = jnp.concatenate([jnp.concatenate([zk, kb[:, :-1]], axis=1), kb], axis=2)
        vv = jnp.concatenate([jnp.concatenate([zk, vb[:, :-1]], axis=1), vb], axis=2)
        starts = start + jnp.arange(nb)[:, None] * SWA_BLOCK
        q_pos = starts + jnp.arange(SWA_BLOCK)
        k_pos = starts - SWA_BLOCK + jnp.arange(2 * SWA_BLOCK)
        out = window_attention(qb, kk, vv, q_pos, k_pos, sinks, rel_bias)
        nbuf = min(WINDOW, l)
        new_k, new_v = k[:, -nbuf:], v[:, -nbuf:]
    else:
        nbuf = k_buf.shape[1]
        kk = jnp.concatenate([k_buf.astype(k.dtype), k], axis=1)
        vv = jnp.concatenate([v_buf.astype(v.dtype), v], axis=1)
        q_pos = start + jnp.arange(l)
        k_pos = start - nbuf + jnp.arange(nbuf + l)
        out = window_attention(q, kk, vv, q_pos, k_pos, sinks, rel_bias)
        new_k, new_v = kk[:, -nbuf:], vv[:, -nbuf:]
    out = out.reshape(bsz, l, nq) @ o_w + o_b
    return out, new_k, new_v


def trunk(x, c, ssm_h0s, conv_bufs, k_bufs, v_bufs, start,
          ada_w, ada_b, norm_pre, norm_post, ffn_w_in, ffn_w_out,
          ssm_in_w, ssm_conv_w, ssm_conv_b, ssm_dt_bias, ssm_a_log, ssm_d, ssm_norm_w, ssm_out_w,
          attn_qkv_w, attn_qkv_b, attn_sinks, attn_o_w, attn_o_b, rel_bias):
    bsz = x.shape[0]
    new_ssm, new_conv, new_k, new_v = [], [], [], []
    cs = jax.nn.silu(c)
    for i in range(DEPTH):
        mod = (cs @ ada_w[i] + ada_b[i]).reshape(bsz, 1, N_SUB, 3, D_MODEL)
        hin = modulated_norm(x, norm_pre[i, 0], mod[:, :, 0])
        f = swiglu(hin, ffn_w_in[i, 0], ffn_w_out[i, 0])
        x = x + FFN_RES * mod[:, :, 0, 2] * rms_norm(f, norm_post[i, 0])
        hin = modulated_norm(x, norm_pre[i, 1], mod[:, :, 1])
        j = i // N_MIXERS
        if i % N_MIXERS == 0:
            o, conv_j, ssm_j = ssd_mixer(hin, conv_bufs[j], ssm_h0s[j], ssm_in_w[j], ssm_conv_w[j], ssm_conv_b[j],
                                         ssm_dt_bias[j], ssm_a_log[j], ssm_d[j], ssm_norm_w[j], ssm_out_w[j])
            new_conv.append(conv_j)
            new_ssm.append(ssm_j)
        else:
            kb = None if k_bufs is None else k_bufs[j]
            vb = None if v_bufs is None else v_bufs[j]
            o, k_j, v_j = swa_mixer(hin, kb, vb, start, attn_qkv_w[j], attn_qkv_b[j], attn_sinks[j],
                                    attn_o_w[j], attn_o_b[j], rel_bias)
            new_k.append(k_j)
            new_v.append(v_j)
        x = x + mod[:, :, 1, 2] * rms_norm(o, norm_post[i, 1])
        hin = modulated_norm(x, norm_pre[i, 2], mod[:, :, 2])
        f = swiglu(hin, ffn_w_in[i, 1], ffn_w_out[i, 1])
        x = x + FFN_RES * mod[:, :, 2, 2] * rms_norm(f, norm_post[i, 2])
    return x, jnp.stack(new_ssm), jnp.stack(new_conv), jnp.stack(new_k), jnp.stack(new_v)


def setup_inputs(seed: int = 0) -> dict:
    key = jax.random.key(seed)
    ks = jax.random.split(key, 32)
    nrm = lambda k, shape, s: jax.random.normal(k, shape, jnp.float32) * s
    nbuf = min(WINDOW, PAST_LEN)
    dt0 = jnp.exp(jax.random.uniform(ks[14], (N_SSM_LAYERS, SSM_HEADS), jnp.float32, math.log(1e-3), math.log(1e-1)))
    return {
        'x_prompt': nrm(ks[0], (BATCH, SEQ, D_MODEL), 1.0),
        'x_sample': nrm(ks[1], (DEC_BATCH, DEC_SEQ, D_MODEL), 1.0),
        'state_ssm': nrm(ks[2], (N_SSM_LAYERS, DEC_BATCH, SSM_HEADS, SSM_HEAD_DIM, SSM_STATE), 0.1),
        'state_conv': nrm(ks[3], (N_SSM_LAYERS, DEC_BATCH, SSM_CONV - 1, SSM_CONV_DIM), 1.0),
        'cache_k': nrm(ks[4], (N_SWA_LAYERS, DEC_BATCH, nbuf, ATTN_KV_HEADS, ATTN_HEAD_DIM), 1.0),
        'cache_v': nrm(ks[5], (N_SWA_LAYERS, DEC_BATCH, nbuf, ATTN_KV_HEADS, ATTN_HEAD_DIM), 1.0),
        'c_prompt': nrm(ks[6], (BATCH, D_MODEL), 1.0),
        'c_sample': nrm(ks[7], (DEC_BATCH, D_MODEL), 1.0),
        'ada_w': nrm(ks[8], (DEPTH, D_MODEL, N_SUB * 3 * D_MODEL), 0.5 * D_MODEL ** -0.5),
        'ada_b': nrm(ks[9], (DEPTH, N_SUB * 3 * D_MODEL), 0.02),
        'norm_pre': 1.0 + nrm(ks[10], (DEPTH, N_SUB, D_MODEL), 0.05),
        'norm_post': 1.0 + nrm(ks[11], (DEPTH, N_SUB, D_MODEL), 0.05),
        'ffn_w_in': nrm(ks[12], (DEPTH, 2, D_MODEL, 2 * D_FF), D_MODEL ** -0.5),
        'ffn_w_out': nrm(ks[13], (DEPTH, 2, D_FF, D_MODEL), D_FF ** -0.5),
        'ssm_in_w': nrm(ks[15], (N_SSM_LAYERS, D_MODEL, SSM_IN_DIM), D_MODEL ** -0.5),
        'ssm_conv_w': nrm(ks[16], (N_SSM_LAYERS, SSM_CONV, SSM_CONV_DIM), SSM_CONV ** -0.5),
        'ssm_conv_b': nrm(ks[17], (N_SSM_LAYERS, SSM_CONV_DIM), 0.02),
        'ssm_dt_bias': dt0 + jnp.log(-jnp.expm1(-dt0)),
        'ssm_a_log': jnp.log(jax.random.uniform(ks[18], (N_SSM_LAYERS, SSM_HEADS), jnp.float32, 1.0, 16.0)),
        'ssm_d': 1.0 + nrm(ks[19], (N_SSM_LAYERS, SSM_HEADS), 0.1),
        'ssm_norm_w': 1.0 + nrm(ks[20], (N_SSM_LAYERS, SSM_D_INNER), 0.05),
        'ssm_out_w': nrm(ks[21], (N_SSM_LAYERS, SSM_D_INNER, D_MODEL), SSM_D_INNER ** -0.5),
        'attn_qkv_w': nrm(ks[22], (N_SWA_LAYERS, D_MODEL, QKV_DIM), D_MODEL ** -0.5),
        'attn_qkv_b': nrm(ks[23], (N_SWA_LAYERS, QKV_DIM), 0.02),
        'attn_sinks': nrm(ks[24], (N_SWA_LAYERS, ATTN_HEADS), 1.0),
        'attn_o_w': nrm(ks[25], (N_SWA_LAYERS, ATTN_HEADS * ATTN_HEAD_DIM, D_MODEL), (ATTN_HEADS * ATTN_HEAD_DIM) ** -0.5),
        'attn_o_b': nrm(ks[26], (N_SWA_LAYERS, D_MODEL), 0.02),
        'rel_bias': nrm(ks[27], (REL_BUCKETS, ATTN_HEADS), 0.5),
    }


def reference(x_prompt, x_sample, state_ssm, state_conv, cache_k, cache_v, c_prompt, c_sample,
              ada_w, ada_b, norm_pre, norm_post, ffn_w_in, ffn_w_out,
              ssm_in_w, ssm_conv_w, ssm_conv_b, ssm_dt_bias, ssm_a_log, ssm_d, ssm_norm_w, ssm_out_w,
              attn_qkv_w, attn_qkv_b, attn_sinks, attn_o_w, attn_o_b, rel_bias):
    weights = (ada_w, ada_b, norm_pre, norm_post, ffn_w_in, ffn_w_out,
               ssm_in_w, ssm_conv_w, ssm_conv_b, ssm_dt_bias, ssm_a_log, ssm_d, ssm_norm_w, ssm_out_w,
               attn_qkv_w, attn_qkv_b, attn_sinks, attn_o_w, attn_o_b, rel_bias)
    bsz = x_prompt.shape[0]
    zero_ssm = jnp.zeros((N_SSM_LAYERS, bsz, SSM_HEADS, SSM_HEAD_DIM, SSM_STATE), x_prompt.dtype)
    zero_conv = jnp.zeros((N_SSM_LAYERS, bsz, SSM_CONV - 1, SSM_CONV_DIM), x_prompt.dtype)
    y_prompt, ssm_p, conv_p, k_p, v_p = trunk(x_prompt, c_prompt, zero_ssm, zero_conv, None, None, 0, *weights)
    y_sample, ssm_s, conv_s, k_s, v_s = trunk(x_sample, c_sample, state_ssm, state_conv, cache_k, cache_v, PAST_LEN, *weights)
    return (y_prompt, y_sample, ssm_p, conv_p, k_p, v_p, ssm_s, conv_s, k_s, v_s)
```

```cpp
#include <hip/hip_runtime.h>
#include <hip/hip_cooperative_groups.h>
#include <cstdio>
#include <cstdint>
namespace cg = cooperative_groups;

#define LAS __attribute__((address_space(3)))
#define GAS __attribute__((address_space(1)))
#define GIN(c_, i_) ((const float*)(const GAS float*)((c_).in[i_]))
typedef unsigned short bf16_t;
typedef short bf16x8 __attribute__((ext_vector_type(8)));
typedef float f32x4 __attribute__((ext_vector_type(4)));
typedef float f32x2 __attribute__((ext_vector_type(2)));
typedef unsigned u32x4 __attribute__((ext_vector_type(4)));
typedef unsigned u32x2 __attribute__((ext_vector_type(2)));

constexpr int D = 1024, TP = 32768, TS = 1024, T = TP + TS, NSEQ = 136, PSEQ = 4096, SSEQ = 8;
constexpr int DFF = 2816, NFF2 = 5632;
constexpr int DIN = 2048, CONVD = 3072, NH = 32, NINP = 5376, NIN_REAL = 5152;
constexpr int QKVD = 1536;
constexpr float EPS = 1e-6f;
constexpr int NCHUNK = T / 128;

constexpr size_t OFF_CTL = 0, CTL_BYTES = 16384;
constexpr size_t OFF_CS = CTL_BYTES;
constexpr size_t OFF_MOD = OFF_CS + 256 * 1024 * 2;
constexpr size_t OFF_PSS = OFF_MOD + (size_t)2 * NSEQ * 9216 * 4;
constexpr size_t OFF_DTS = OFF_PSS + (size_t)T * 16 * 4;
constexpr size_t OFF_ACS = OFF_DTS + (size_t)T * 32 * 4;
constexpr size_t OFF_HALO = OFF_ACS + (size_t)T * 32 * 4;
constexpr size_t OFF_WIN = OFF_HALO + (size_t)NCHUNK * 3 * CONVD * 2;
constexpr size_t OFF_WOUT = OFF_WIN + (size_t)4 * NFF2 * D * 2;
constexpr size_t OFF_SSMIN = OFF_WOUT + (size_t)4 * D * DFF * 2;
constexpr size_t OFF_SSMOUT = OFF_SSMIN + (size_t)NINP * D * 2;
constexpr size_t OFF_QKVW = OFF_SSMOUT + (size_t)D * DIN * 2;
constexpr size_t OFF_OW = OFF_QKVW + (size_t)QKVD * D * 2;
constexpr size_t OFF_HIN = OFF_OW + (size_t)D * D * 2;
constexpr size_t OFF_R = OFF_HIN + (size_t)T * D * 2;
constexpr size_t R_BYTES = (size_t)T * 5120 * 2;
constexpr size_t WS_NEED = OFF_R + R_BYTES;
static_assert(WS_NEED <= 536870912ull, "workspace map must fit 512 MiB");
constexpr size_t OFF_ACT = OFF_R;
constexpr size_t OFF_F = OFF_R + (size_t)T * DFF * 2;
constexpr size_t OFF_Z = OFF_R;
constexpr size_t OFF_XBC = OFF_R + (size_t)T * DIN * 2;
constexpr size_t OFF_QKV = OFF_R;
constexpr size_t OFF_AO = OFF_R + (size_t)T * QKVD * 2;
constexpr size_t OFF_ADAT = OFF_R;
constexpr size_t OFF_PART = OFF_F + (size_t)T * D * 2;
static_assert(OFF_PART + (size_t)11 * TS * D * 4 <= OFF_R + R_BYTES, "partials overlay");
static_assert(OFF_AO + (size_t)T * D * 2 <= OFF_F, "swa overlay");
static_assert(OFF_F + (size_t)T * D * 2 <= OFF_R + R_BYTES, "F overlay");
static_assert(OFF_F >= OFF_Z + (size_t)T * DIN * 2, "F must not overlap yn");

constexpr size_t O_Y = 0;
constexpr size_t O_SSMP = (size_t)T * D;
constexpr size_t O_CONVP = O_SSMP + (size_t)8 * 32 * 64 * 128;
constexpr size_t O_KP = O_CONVP + (size_t)8 * 3 * CONVD;
constexpr size_t O_VP = O_KP + (size_t)8 * 128 * 256;
constexpr size_t O_SSMS = O_VP + (size_t)8 * 128 * 256;
constexpr size_t O_CONVS = O_SSMS + (size_t)128 * 32 * 64 * 128;
constexpr size_t O_KS = O_CONVS + (size_t)128 * 3 * CONVD;
constexpr size_t O_VS = O_KS + (size_t)128 * 128 * 256;

constexpr int LDS_BYTES = 147456;
constexpr int NWAVES = 8;

__device__ __forceinline__ unsigned f2bf(float f) { unsigned u = __builtin_bit_cast(unsigned, f); return (u + 0x7fffu + ((u >> 16) & 1u)) >> 16; }
__device__ __forceinline__ unsigned pk2(float lo, float hi) { return f2bf(lo) | (f2bf(hi) << 16); }
typedef __bf16 bf16x2_t __attribute__((ext_vector_type(2)));
__device__ __forceinline__ unsigned cvt_pk_bf16(float lo, float hi) { f32x2 v = {lo, hi}; bf16x2_t b = __builtin_convertvector(v, bf16x2_t); return __builtin_bit_cast(unsigned, b); }
__device__ __forceinline__ float bflo(unsigned w) { return __uint_as_float(w << 16); }
__device__ __forceinline__ float bfhi(unsigned w) { return __uint_as_float(w & 0xffff0000u); }
__device__ __forceinline__ float bf1(bf16_t b) { return __uint_as_float((unsigned)b << 16); }
__device__ __forceinline__ float silu_f(float g) { return g * __builtin_amdgcn_rcpf(1.0f + __expf(-g)); }
__device__ __forceinline__ float wave_sum(float v) {
#pragma unroll
    for (int o = 1; o < 64; o <<= 1) v += __shfl_xor(v, o);
    return v;
}
__device__ __forceinline__ int seq_of(int row) { return row < TP ? (row >> 12) : 8 + ((row - TP) >> 3); }

namespace pg8 {
#define PG8_LAS __attribute__((address_space(3)))
constexpr int BM = 256, BK = 64, HALF = 128, HTB = HALF * BK * 2, STAGE_BYTES = 8 * HTB, NXCD = 8, WGM = 8;
__host__ __device__ __forceinline__ int lds_byte(int r, int c) { const int st = (r >> 4) * 2 + (c >> 5), rr = r & 15, cc = c & 31, ob = rr * 64 + cc * 2; return st * 1024 + (ob ^ (((ob >> 9) & 1) << 5)); }
__host__ __device__ __forceinline__ void stage_rc(int b, int& R, int& C) { const int st = b / 1024, sb = b % 1024, swz = sb ^ (((sb >> 9) & 1) << 5); R = (st >> 1) * 16 + swz / 64; C = (st & 1) * 32 + (swz % 64) / 2; }
__host__ __device__ __forceinline__ int perm32(int rho) { const int n = rho >> 4, i = rho & 15; return 8 * (i >> 2) + 4 * n + (i & 3); }
struct Unit { int pm, pn; };
struct Gemm { const bf16_t* A; const bf16_t* Bt; int M, N, K; int Kloop; };
struct StaticOrder {
    int nM, nN, nwg, G, c, sl;
    __host__ __device__ void init(int M, int N, int G_, int c_) { nM = M / BM; nN = N / BM; nwg = nM * nN; G = G_; c = c_; sl = 0; }
    __host__ __device__ void init_slices(int S, int G_, int c_, int nn = 4) { nM = 4; nN = nn; nwg = 4 * nn * S; G = G_; c = c_; sl = 1; }
    __host__ __device__ bool next(int i, Unit& u) const {
        const long L = (long)i * G + c; if (L >= nwg) return false;
        if (sl) { if (i > 0) return false; const int t_ = (int)L % (4 * nN); u.pm = t_ / nN; u.pn = t_ % nN; return true; }
        int wgid = (int)L; { const int q = nwg / NXCD, r = nwg % NXCD, xcd = wgid % NXCD, off = wgid / NXCD; wgid = (xcd < r ? xcd * (q + 1) : r * (q + 1) + (xcd - r) * q) + off; }
        const int nig = WGM * nN, gid = wgid / nig, fm = gid * WGM, gsz = (nM - fm) < WGM ? (nM - fm) : WGM;
        u.pm = fm + ((wgid % nig) % gsz); u.pn = (wgid % nig) / gsz; return true;
    }
    __device__ __forceinline__ void a_ready(const Unit&) const {}
    __device__ __forceinline__ void done(const Unit&) const {}
};

template <class Epi, class Sched, bool ALIGN_EPI = false, bool SP2 = false>
__device__ __forceinline__ void gemm_phase(PG8_LAS unsigned char* lds, const Gemm g, const Sched& S, const Epi& E, const int tid) {
    const int wid = __builtin_amdgcn_readfirstlane(tid >> 6), lane = tid & 63, wr = wid >> 2, wc = wid & 3, fr = lane & 15, fq = lane >> 4;
    const int K = g.K, nt = (g.Kloop ? g.Kloop : g.K) / BK;
    unsigned voffA[2], voffB[2];
#pragma unroll
    for (int i = 0; i < 2; ++i) { int R, C; stage_rc(tid * 16 + i * 8192, R, C); const int Rb = Epi::PERM ? ((R & ~31) + perm32(R & 31)) : R;
        voffA[i] = (unsigned)(R * K + C) * 2u; voffB[i] = (unsigned)(Rb * K + C) * 2u; }
    const size_t kstep = (size_t)(BK * 2);
    const size_t hstep = (size_t)HALF * K * 2;
    const size_t tstep = 2 * hstep;
    const unsigned ldsw = (unsigned)wid * 1024u;
    const int aoff = lds_byte(wr * 64 + fr, fq * 8), boff = lds_byte(wc * 32 + fr, fq * 8);
#define PG8_SA(b, h) (((b) * 2 + (h)) * HTB)
#define PG8_SB(b, h) ((4 + (b) * 2 + (h)) * HTB)
#define PG8_STAGE(bufoff, gbase, voff) do { _Pragma("unroll") for (int _i = 0; _i < 2; ++_i) \
        __builtin_amdgcn_global_load_lds((const unsigned*)((const char*)(gbase) + (voff)[_i]), (PG8_LAS unsigned*)(lds + (bufoff) + ldsw + _i * 8192), 16, 0, 0); } while (0)
#define PG8_LDA(dst, b, h) do { _Pragma("unroll") for (int m = 0; m < 4; ++m) _Pragma("unroll") for (int k = 0; k < 2; ++k) dst[m][k] = *(const PG8_LAS bf16x8*)(lds + PG8_SA(b, h) + aoff + m * 2048 + k * 1024); } while (0)
#define PG8_LDB(dst, b, h) do { _Pragma("unroll") for (int n = 0; n < 2; ++n) _Pragma("unroll") for (int k = 0; k < 2; ++k) dst[n][k] = *(const PG8_LAS bf16x8*)(lds + PG8_SB(b, h) + boff + n * 2048 + k * 1024); } while (0)
#define PG8_MMA(ai, bj, At, Bt) do { __builtin_amdgcn_s_setprio(1); _Pragma("unroll") for (int m = 0; m < 4; ++m) _Pragma("unroll") for (int n = 0; n < 2; ++n) _Pragma("unroll") for (int k = 0; k < 2; ++k) \
        acc[ai][bj][m][n] = __builtin_amdgcn_mfma_f32_16x16x32_bf16(Bt[n][k], At[m][k], acc[ai][bj][m][n], 0, 0, 0); __builtin_amdgcn_s_setprio(0); } while (0)
#define PG8_WAIT_V(n) asm volatile("s_waitcnt vmcnt(" #n ")" ::: "memory")
#define PG8_WAIT_L(n) asm volatile("s_waitcnt lgkmcnt(" #n ")" ::: "memory")
#define PG8_BAR __builtin_amdgcn_s_barrier()
#define PG8_SCHED __builtin_amdgcn_sched_barrier(0)
    Unit cur, nxt; int ui = 0;
    if (!S.next(0, cur)) return;
    f32x4 acc[2][2][4][2];
#pragma unroll
    for (int a = 0; a < 2; ++a)
#pragma unroll
        for (int b = 0; b < 2; ++b)
#pragma unroll
            for (int m = 0; m < 4; ++m)
#pragma unroll
                for (int n = 0; n < 2; ++n) acc[a][b][m][n] = (f32x4){0.f, 0.f, 0.f, 0.f};
    bf16x8 At[4][2], B0[2][2], B1[2][2];
    const char* cA = (const char*)g.A + (size_t)cur.pm * tstep; const char* cB = (const char*)g.Bt + (size_t)cur.pn * tstep;
    S.a_ready(cur);
    if constexpr (SP2) {
        PG8_STAGE(PG8_SB(0, 0), cB, voffB); PG8_STAGE(PG8_SB(0, 1), cB + hstep, voffB); PG8_STAGE(PG8_SA(0, 0), cA, voffA); PG8_STAGE(PG8_SA(0, 1), cA + hstep, voffA);
        if (wr == 1) PG8_BAR;
        PG8_WAIT_V(2); PG8_BAR;
        PG8_STAGE(PG8_SB(1, 0), cB + kstep, voffB); PG8_STAGE(PG8_SA(1, 0), cA + kstep, voffA); PG8_STAGE(PG8_SB(1, 1), cB + hstep + kstep, voffB);
        PG8_WAIT_V(6); PG8_BAR;
    } else {
        PG8_STAGE(PG8_SB(0, 0), cB, voffB); PG8_STAGE(PG8_SA(0, 0), cA, voffA); PG8_STAGE(PG8_SB(0, 1), cB + hstep, voffB); PG8_STAGE(PG8_SA(0, 1), cA + hstep, voffA);
        if (wr == 1) PG8_BAR;
        PG8_WAIT_V(4); PG8_BAR;
        PG8_STAGE(PG8_SB(1, 0), cB + kstep, voffB); PG8_STAGE(PG8_SA(1, 0), cA + kstep, voffA); PG8_STAGE(PG8_SB(1, 1), cB + hstep + kstep, voffB);
        PG8_WAIT_V(6); PG8_BAR;
    }
    for (;;) {
        const bool has_next = S.next(ui + 1, nxt);
        const char* nA = has_next ? (const char*)g.A + (size_t)nxt.pm * tstep : cA; const char* nB = has_next ? (const char*)g.Bt + (size_t)nxt.pn * tstep : cB;
        for (int t = 0; t < nt; t += 2) {
            const bool last = (t == nt - 2);
            const char* a1 = cA + (size_t)(t + 1) * kstep;
            const char* a2 = last ? nA : cA + (size_t)(t + 2) * kstep; const char* b2 = last ? nB : cB + (size_t)(t + 2) * kstep;
            const char* a3 = a2 + kstep; const char* b3 = b2 + kstep;
            if (last && has_next) S.a_ready(nxt);
            if constexpr (SP2) {
            PG8_LDB(B0, 0, 0); PG8_LDB(B1, 0, 1); PG8_SCHED; PG8_LDA(At, 0, 0); PG8_STAGE(PG8_SA(1, 1), a1 + hstep, voffA);
            PG8_WAIT_V(8); PG8_WAIT_L(0); PG8_BAR; PG8_MMA(0, 0, At, B0); PG8_MMA(0, 1, At, B1); PG8_BAR; PG8_SCHED;
            PG8_LDA(At, 0, 1); PG8_STAGE(PG8_SB(0, 0), b2, voffB); PG8_STAGE(PG8_SB(0, 1), b2 + hstep, voffB); PG8_STAGE(PG8_SA(0, 0), a2, voffA);
            PG8_WAIT_V(8); PG8_WAIT_L(0); PG8_BAR; PG8_MMA(1, 0, At, B0); PG8_MMA(1, 1, At, B1); PG8_BAR; PG8_SCHED;
            PG8_LDB(B0, 1, 0); PG8_LDB(B1, 1, 1); PG8_SCHED; PG8_LDA(At, 1, 0); PG8_STAGE(PG8_SA(0, 1), a2 + hstep, voffA);
            PG8_WAIT_V(8); PG8_WAIT_L(0); PG8_BAR; PG8_MMA(0, 0, At, B0); PG8_MMA(0, 1, At, B1); PG8_BAR; PG8_SCHED;
            PG8_LDA(At, 1, 1); PG8_STAGE(PG8_SB(1, 0), b3, voffB); PG8_STAGE(PG8_SB(1, 1), b3 + hstep, voffB); PG8_STAGE(PG8_SA(1, 0), a3, voffA);
            PG8_WAIT_V(8); PG8_WAIT_L(0); PG8_BAR; PG8_MMA(1, 0, At, B0); PG8_MMA(1, 1, At, B1); PG8_BAR; PG8_SCHED;
            } else {
            PG8_LDB(B0, 0, 0); PG8_SCHED; PG8_LDA(At, 0, 0); PG8_STAGE(PG8_SA(1, 1), a1 + hstep, voffA);
            PG8_WAIT_L(8); PG8_BAR; PG8_WAIT_L(0); PG8_MMA(0, 0, At, B0); PG8_BAR; PG8_SCHED;
            PG8_LDB(B1, 0, 1); PG8_STAGE(PG8_SB(0, 0), b2, voffB);
            PG8_BAR; PG8_WAIT_L(0); PG8_MMA(0, 1, At, B1); PG8_BAR;
            PG8_LDA(At, 0, 1); PG8_STAGE(PG8_SA(0, 0), a2, voffA);
            PG8_BAR; PG8_WAIT_L(0); PG8_MMA(1, 0, At, B0); PG8_BAR; PG8_SCHED;
            PG8_STAGE(PG8_SB(0, 1), b2 + hstep, voffB);
            PG8_WAIT_V(6); PG8_BAR; PG8_MMA(1, 1, At, B1); PG8_BAR;
            PG8_LDB(B0, 1, 0); PG8_SCHED; PG8_LDA(At, 1, 0); PG8_STAGE(PG8_SA(0, 1), a2 + hstep, voffA);
            PG8_WAIT_L(8); PG8_BAR; PG8_WAIT_L(0); PG8_MMA(0, 0, At, B0); PG8_BAR; PG8_SCHED;
            PG8_LDB(B1, 1, 1); PG8_STAGE(PG8_SB(1, 0), b3, voffB);
            PG8_BAR; PG8_WAIT_L(0); PG8_MMA(0, 1, At, B1); PG8_BAR;
            PG8_LDA(At, 1, 1); PG8_STAGE(PG8_SA(1, 0), a3, voffA);
            PG8_BAR; PG8_WAIT_L(0); PG8_MMA(1, 0, At, B0); PG8_BAR; PG8_SCHED;
            PG8_STAGE(PG8_SB(1, 1), b3 + hstep, voffB);
            PG8_WAIT_V(6); PG8_BAR; PG8_MMA(1, 1, At, B1); PG8_BAR;
            }
        }
        if constexpr (ALIGN_EPI) { if (wr == 0) PG8_BAR; }
        E(acc, cur, wr, wc, fr, fq);
        if (!has_next) break;
#pragma unroll
        for (int a = 0; a < 2; ++a)
#pragma unroll
            for (int b = 0; b < 2; ++b)
#pragma unroll
                for (int m = 0; m < 4; ++m)
#pragma unroll
                    for (int n = 0; n < 2; ++n) acc[a][b][m][n] = (f32x4){0.f, 0.f, 0.f, 0.f};
        cur = nxt; cA = nA; cB = nB; ++ui;
        if constexpr (ALIGN_EPI) { if (wr == 1) PG8_BAR; }
    }
    PG8_WAIT_V(0);
    if constexpr (!ALIGN_EPI) { if (wr == 0) PG8_BAR; }
    PG8_BAR;
#undef PG8_SA
#undef PG8_SB
#undef PG8_STAGE
#undef PG8_LDA
#undef PG8_LDB
#undef PG8_MMA
#undef PG8_WAIT_V
#undef PG8_WAIT_L
#undef PG8_BAR
#undef PG8_SCHED
}
}

typedef f32x4 AccT[2][2][4][2];

struct EpiSwiglu {
    static constexpr bool PERM = true;
    bf16_t* O;
    __device__ __forceinline__ void operator()(const AccT& acc, const pg8::Unit& u, int wr, int wc, int fr, int fq) const {
        const int row0 = u.pm * 256 + wr * 64 + fr, col0 = u.pn * 128 + wc * 32 + 8 * fq;
#pragma unroll
        for (int ai = 0; ai < 2; ++ai)
#pragma unroll
            for (int m = 0; m < 4; ++m) {
                bf16_t* p = O + (size_t)(row0 + ai * 128 + m * 16) * DFF + col0;
                const f32x4 g0 = acc[ai][0][m][0], g1 = acc[ai][0][m][1], u0 = acc[ai][1][m][0], u1 = acc[ai][1][m][1];
                u32x4 w;
                w.x = cvt_pk_bf16(silu_f(g0[0]) * u0[0], silu_f(g0[1]) * u0[1]); w.y = cvt_pk_bf16(silu_f(g0[2]) * u0[2], silu_f(g0[3]) * u0[3]);
                w.z = cvt_pk_bf16(silu_f(g1[0]) * u1[0], silu_f(g1[1]) * u1[1]); w.w = cvt_pk_bf16(silu_f(g1[2]) * u1[2], silu_f(g1[3]) * u1[3]);
                *(u32x4*)p = w;
            }
    }
};
struct EpiRows {
    static constexpr bool PERM = true;
    bf16_t* O; const float* bias; float* pss; float* part;
    __device__ __forceinline__ void operator()(const AccT& acc, const pg8::Unit& u, int wr, int wc, int fr, int fq) const {
        const int row0 = u.pm * 256 + wr * 64 + fr, col0 = u.pn * 256 + wc * 32 + 8 * fq;
        if (part) {
            float* rp = part + (size_t)row0 * D + col0;
#pragma unroll
            for (int ai = 0; ai < 2; ++ai) {
#pragma unroll
                for (int m = 0; m < 4; ++m) {
#pragma unroll
                    for (int bj = 0; bj < 2; ++bj) { *(f32x4*)(rp + bj * 128) = acc[ai][bj][m][0]; *(f32x4*)(rp + bj * 128 + 4) = acc[ai][bj][m][1]; }
                    rp += 16 * D;
                }
                rp += 64 * D;
            }
            return;
        }
        f32x4 bv[2][2];
#pragma unroll
        for (int bj = 0; bj < 2; ++bj)
#pragma unroll
            for (int n = 0; n < 2; ++n) bv[bj][n] = bias ? *(const f32x4*)(bias + col0 + bj * 128 + 4 * n) : (f32x4){0.f, 0.f, 0.f, 0.f};
#pragma unroll
        for (int ai = 0; ai < 2; ++ai)
#pragma unroll
            for (int m = 0; m < 4; ++m) {
                const int row = row0 + ai * 128 + m * 16;
                float ss = 0.f;
#pragma unroll
                for (int bj = 0; bj < 2; ++bj) {
                    const f32x4 v0 = acc[ai][bj][m][0] + bv[bj][0], v1 = acc[ai][bj][m][1] + bv[bj][1];
                    ss += (v0[0] * v0[0] + v0[1] * v0[1]) + (v0[2] * v0[2] + v0[3] * v0[3]) + (v1[0] * v1[0] + v1[1] * v1[1]) + (v1[2] * v1[2] + v1[3] * v1[3]);
                    u32x4 w; w.x = cvt_pk_bf16(v0[0], v0[1]); w.y = cvt_pk_bf16(v0[2], v0[3]); w.z = cvt_pk_bf16(v1[0], v1[1]); w.w = cvt_pk_bf16(v1[2], v1[3]);
                    *(u32x4*)(O + (size_t)row * D + col0 + bj * 128) = w;
                }
                ss += __shfl_xor(ss, 16); ss += __shfl_xor(ss, 32);
                if (fq == 0) pss[(size_t)row * 16 + u.pn * 4 + wc] = ss;
            }
    }
};
struct EpiMod {
    static constexpr bool PERM = true;
    float* O; const float* bias;
    __device__ __forceinline__ void operator()(const AccT& acc, const pg8::Unit& u, int wr, int wc, int fr, int fq) const {
        const int row0 = u.pm * 256 + wr * 64 + fr, col0 = u.pn * 256 + wc * 32 + 8 * fq;
#pragma unroll
        for (int ai = 0; ai < 2; ++ai)
#pragma unroll
            for (int m = 0; m < 4; ++m) {
                const int row = row0 + ai * 128 + m * 16;
                if (row < NSEQ) {
#pragma unroll
                    for (int bj = 0; bj < 2; ++bj) {
                        const int c = col0 + bj * 128; const int l = c / 9216, cc = c - l * 9216;
                        float* p = O + ((size_t)l * NSEQ + row) * 9216 + cc;
                        *(f32x4*)p = acc[ai][bj][m][0] + *(const f32x4*)(bias + c);
                        *(f32x4*)(p + 4) = acc[ai][bj][m][1] + *(const f32x4*)(bias + c + 4);
                    }
                }
            }
    }
};
struct EpiInproj {
    static constexpr bool PERM = true;
    bf16_t* Z; bf16_t* XBC; bf16_t* HALO; float* DTS; const float* dt_bias;
    __device__ __forceinline__ void operator()(const AccT& acc, const pg8::Unit& u, int wr, int wc, int fr, int fq) const {
        const int row0 = u.pm * 256 + wr * 64 + fr, col0 = u.pn * 256 + wc * 32 + 8 * fq;
        if (u.pn == 20) {
            if (wc == 0) {
                const f32x4 b0 = *(const f32x4*)(dt_bias + 8 * fq), b1 = *(const f32x4*)(dt_bias + 8 * fq + 4);
#pragma unroll
                for (int ai = 0; ai < 2; ++ai)
#pragma unroll
                    for (int m = 0; m < 4; ++m) {
                        const int row = row0 + ai * 128 + m * 16;
                        f32x4 v0 = acc[ai][0][m][0] + b0, v1 = acc[ai][0][m][1] + b1;
#pragma unroll
                        for (int e = 0; e < 4; ++e) { v0[e] = v0[e] > 20.f ? v0[e] : log1pf(__expf(v0[e])); v1[e] = v1[e] > 20.f ? v1[e] : log1pf(__expf(v1[e])); }
                        *(f32x4*)(DTS + (size_t)row * 32 + 8 * fq) = v0; *(f32x4*)(DTS + (size_t)row * 32 + 8 * fq + 4) = v1;
                    }
            }
            return;
        }
        const bool isz = u.pn < 8;
        bf16_t* base = isz ? Z : XBC; const int ld = isz ? DIN : CONVD; const int cb = isz ? col0 : col0 - DIN;
#pragma unroll
        for (int ai = 0; ai < 2; ++ai)
#pragma unroll
            for (int m = 0; m < 4; ++m) {
                const int row = row0 + ai * 128 + m * 16;
#pragma unroll
                for (int bj = 0; bj < 2; ++bj) {
                    const f32x4 v0 = acc[ai][bj][m][0], v1 = acc[ai][bj][m][1];
                    u32x4 w; w.x = cvt_pk_bf16(v0[0], v0[1]); w.y = cvt_pk_bf16(v0[2], v0[3]); w.z = cvt_pk_bf16(v1[0], v1[1]); w.w = cvt_pk_bf16(v1[2], v1[3]);
                    *(u32x4*)(base + (size_t)row * ld + cb + bj * 128) = w;
                    if (!isz && (row & 127) >= 125) *(u32x4*)(HALO + ((size_t)(row >> 7) * 3 + ((row & 127) - 125)) * CONVD + cb + bj * 128) = w;
                }
            }
    }
};
struct EpiQkv {
    static constexpr bool PERM = true;
    bf16_t* O; const float* bias; float* part;
    __device__ __forceinline__ void operator()(const AccT& acc, const pg8::Unit& u, int wr, int wc, int fr, int fq) const {
        const int row0 = u.pm * 256 + wr * 64 + fr, col0 = u.pn * 256 + wc * 32 + 8 * fq;
        if (part) {
            float* rp = part + (size_t)row0 * QKVD + col0;
#pragma unroll
            for (int ai = 0; ai < 2; ++ai) {
#pragma unroll
                for (int m = 0; m < 4; ++m) {
#pragma unroll
                    for (int bj = 0; bj < 2; ++bj) { *(f32x4*)(rp + bj * 128) = acc[ai][bj][m][0]; *(f32x4*)(rp + bj * 128 + 4) = acc[ai][bj][m][1]; }
                    rp += 16 * QKVD;
                }
                rp += 64 * QKVD;
            }
            return;
        }
        f32x4 bv[2][2];
#pragma unroll
        for (int bj = 0; bj < 2; ++bj)
#pragma unroll
            for (int n = 0; n < 2; ++n) bv[bj][n] = *(const f32x4*)(bias + col0 + bj * 128 + 4 * n);
#pragma unroll
        for (int ai = 0; ai < 2; ++ai)
#pragma unroll
            for (int m = 0; m < 4; ++m) {
                const int row = row0 + ai * 128 + m * 16;
#pragma unroll
                for (int bj = 0; bj < 2; ++bj) {
                    const f32x4 v0 = acc[ai][bj][m][0] + bv[bj][0], v1 = acc[ai][bj][m][1] + bv[bj][1];
                    u32x4 w; w.x = cvt_pk_bf16(v0[0], v0[1]); w.y = cvt_pk_bf16(v0[2], v0[3]); w.z = cvt_pk_bf16(v1[0], v1[1]); w.w = cvt_pk_bf16(v1[2], v1[3]);
                    *(u32x4*)(O + (size_t)row * QKVD + col0 + bj * 128) = w;
                }
            }
    }
};

struct Args { const float* in[28]; float* out; unsigned char* ws; };

struct Ctx {
    LAS unsigned char* lds;
    int tid, lane, wave, gw, ngw, G, bid;
    const float* const* in;
    float* out; unsigned char* ws; bool dry;
    float* out2; unsigned char* ws2;
};

__device__ __forceinline__ void p0_item(const float* W, int N, int K, bf16_t* WT, int dest_row0, int src_col0, int k0, LAS float* scr, int lane) {
    if (src_col0 >= 0) {
        float wv[32];
#pragma unroll
        for (int i = 0; i < 32; ++i) wv[i] = W[(size_t)(k0 + 2 * i + (lane >> 5)) * N + src_col0 + (lane & 31)];
#pragma unroll
        for (int i = 0; i < 32; ++i) scr[(2 * i + (lane >> 5)) * 33 + (lane & 31)] = wv[i];
    } else {
#pragma unroll 8
        for (int i = 0; i < 32; ++i) { const int kk = 2 * i + (lane >> 5); scr[kk * 33 + (lane & 31)] = 0.f; }
    }
    asm volatile("s_waitcnt lgkmcnt(0)" ::: "memory");
    const int c = lane & 7;
#pragma unroll
    for (int j = 0; j < 4; ++j) { const int n = (lane >> 3) + 8 * j; const LAS float* s = scr + (8 * c) * 33 + n;
        u32x4 o; o.x = cvt_pk_bf16(s[0 * 33], s[1 * 33]); o.y = cvt_pk_bf16(s[2 * 33], s[3 * 33]); o.z = cvt_pk_bf16(s[4 * 33], s[5 * 33]); o.w = cvt_pk_bf16(s[6 * 33], s[7 * 33]);
        *(u32x4*)(WT + (size_t)(dest_row0 + n) * K + k0 + 8 * c) = o; }
    asm volatile("s_waitcnt lgkmcnt(0)" ::: "memory");
}
__device__ __forceinline__ void p0_run(const Ctx& c, int lo1, int n1, int lo2, int n2, int lo3, int n3, int vw, int nvw) {
    LAS float* scr = (LAS float*)(c.lds + c.wave * 16384);
    constexpr int I_ADA = 2 * 16 * 288, I_WIN = 4 * 16 * 176, I_WOUT = 4 * 44 * 32, I_SIN = 16 * 168, I_SOUT = 32 * 32, I_QKV = 16 * 48, I_O = 16 * 32;
    for (int v = vw; v < n1 + n2 + n3; v += nvw) {
        int r = v < n1 ? lo1 + v : (v < n1 + n2 ? lo2 + (v - n1) : lo3 + (v - n1 - n2));
        if (r < I_ADA) { const int l = r / 4608, rr = r % 4608, kb = rr / 288, nb = rr % 288;
            p0_item(GIN(c, 8) + (size_t)l * 1024 * 9216, 9216, 1024, (bf16_t*)(c.ws + OFF_ADAT), l * 9216 + nb * 32, nb * 32, kb * 64, scr, c.lane); continue; } r -= I_ADA;
        if (r < I_WIN) { const int f = r / 2816, rr = r % 2816, kb = rr / 176, nb = rr % 176; const int d0 = nb * 32, pn = d0 >> 8, bj = (d0 >> 7) & 1, cc = d0 & 127;
            p0_item(GIN(c, 12) + (size_t)f * 1024 * NFF2, NFF2, 1024, (bf16_t*)(c.ws + OFF_WIN) + (size_t)f * NFF2 * 1024, d0, bj * DFF + pn * 128 + cc, kb * 64, scr, c.lane); continue; } r -= I_WIN;
        if (r < I_WOUT) { const int f = r / 1408, rr = r % 1408, kb = rr / 32, nb = rr % 32;
            p0_item(GIN(c, 13) + (size_t)f * DFF * 1024, 1024, DFF, (bf16_t*)(c.ws + OFF_WOUT) + (size_t)f * 1024 * DFF, nb * 32, nb * 32, kb * 64, scr, c.lane); continue; } r -= I_WOUT;
        if (r < I_SIN) { const int kb = r / 168, nb = r % 168;
            p0_item(GIN(c, 14), NIN_REAL, 1024, (bf16_t*)(c.ws + OFF_SSMIN), nb * 32, nb < 161 ? nb * 32 : -1, kb * 64, scr, c.lane); continue; } r -= I_SIN;
        if (r < I_SOUT) { const int kb = r / 32, nb = r % 32;
            p0_item(GIN(c, 21), 1024, DIN, (bf16_t*)(c.ws + OFF_SSMOUT), nb * 32, nb * 32, kb * 64, scr, c.lane); continue; } r -= I_SOUT;
        if (r < I_QKV) { const int kb = r / 48, nb = r % 48;
            p0_item(GIN(c, 22), QKVD, 1024, (bf16_t*)(c.ws + OFF_QKVW), nb * 32, nb * 32, kb * 64, scr, c.lane); continue; } r -= I_QKV;
        { const int kb = r / 32, nb = r % 32;
            p0_item(GIN(c, 25), 1024, 1024, (bf16_t*)(c.ws + OFF_OW), nb * 32, nb * 32, kb * 64, scr, c.lane); }
    }
}
__device__ __forceinline__ void p0_phase(const Ctx& c) {
    p0_run(c, 0, 12032, 0, 0, 0, 0, c.gw, c.ngw);
    bf16_t* CS = (bf16_t*)(c.ws + OFF_CS);
    for (int row = c.gw; row < 256; row += c.ngw) {
        const float* src = row < 8 ? GIN(c, 6) + (size_t)row * D : (row < NSEQ ? GIN(c, 7) + (size_t)(row - 8) * D : nullptr);
#pragma unroll
        for (int j = 0; j < 4; ++j) {
            f32x4 v = src ? *(const f32x4*)(src + 4 * (c.lane + 64 * j)) : (f32x4){0.f, 0.f, 0.f, 0.f};
            if (src) { v[0] = silu_f(v[0]); v[1] = silu_f(v[1]); v[2] = silu_f(v[2]); v[3] = silu_f(v[3]); }
            u32x2 w; w.x = pk2(v[0], v[1]); w.y = pk2(v[2], v[3]);
            *(u32x2*)(CS + (size_t)row * D + 4 * (c.lane + 64 * j)) = w;
        }
    }
}

struct NormRow { f32x4 v[4]; u32x2 xb[4]; u32x2 f[4]; float p; };
__device__ __forceinline__ void norm_load(NormRow& r, const float* xin, const bf16_t* F, const float* PSS, int row, int lane, bool has_upd, bool xf32) {
    if (xf32) {
#pragma unroll
        for (int j = 0; j < 4; ++j) r.v[j] = *(const f32x4*)(xin + 4 * (lane + 64 * j));
    } else {
#pragma unroll
        for (int j = 0; j < 4; ++j) r.xb[j] = *(const u32x2*)((const bf16_t*)xin + 4 * (lane + 64 * j));
    }
    if (has_upd) {
#pragma unroll
        for (int j = 0; j < 4; ++j) r.f[j] = *(const u32x2*)(F + (size_t)row * D + 4 * (lane + 64 * j));
        r.p = PSS[(size_t)row * 16 + (lane & 15)];
    }
}
__device__ __forceinline__ void norm_phase(const Ctx& c, int s) {
    const bool has_upd = s > 0, has_out = s < 6, xf32 = s <= 1;
    const int sp = s > 0 ? s - 1 : 0, lp = sp / 3, subp = sp % 3, l = has_out ? s / 3 : 0, sub = has_out ? s % 3 : 0;
    const float coef = (subp == 1) ? 1.0f : 0.5f;
    const float* MOD = (const float*)(c.ws + OFF_MOD);
    const float* PSS = (const float*)(c.ws + OFF_PSS);
    const bf16_t* F = (const bf16_t*)(c.ws + OFF_F);
    bf16_t* HIN = (bf16_t*)(c.ws + OFF_HIN);
    const float* post = GIN(c, 11) + (size_t)(lp * 3 + subp) * D;
    const float* pre = GIN(c, 10) + (size_t)(l * 3 + sub) * D;
    float* xo = c.dry ? (float*)(c.ws + OFF_XBC) : c.out;
    const int lane = c.lane;
    f32x4 gp[4], am[4], sh[4];
    int cur_seq = -1;
#define NORM_PARAMS(seq_) do { if ((seq_) != cur_seq) { cur_seq = (seq_); \
        const float* gate_ = MOD + ((size_t)lp * NSEQ + (seq_)) * 9216 + subp * 3072 + 2048; \
        const float* shift_ = MOD + ((size_t)l * NSEQ + (seq_)) * 9216 + sub * 3072; \
        _Pragma("unroll") for (int j = 0; j < 4; ++j) { const int col = 4 * (lane + 64 * j); \
            if (has_upd) gp[j] = *(const f32x4*)(gate_ + col) * *(const f32x4*)(post + col) * coef; \
            if (has_out) { sh[j] = *(const f32x4*)(shift_ + col); am[j] = *(const f32x4*)(pre + col) * (*(const f32x4*)(shift_ + 1024 + col) + 1.0f); } } } } while (0)
#define NORM_BODY(row_, v, fv, rf) do { \
        if (has_upd) { _Pragma("unroll") for (int j = 0; j < 4; ++j) { v[j] = v[j] + gp[j] * fv[j] * (rf); \
                if (has_out) { u32x2 w_; w_.x = cvt_pk_bf16(v[j][0], v[j][1]); w_.y = cvt_pk_bf16(v[j][2], v[j][3]); *(u32x2*)((bf16_t*)(xo + (size_t)(row_) * D) + 4 * (lane + 64 * j)) = w_; } \
                else *(f32x4*)(xo + (size_t)(row_) * D + 4 * (lane + 64 * j)) = v[j]; } } \
        if (has_out) { float ss_ = 0.f; \
            _Pragma("unroll") for (int j = 0; j < 4; ++j) ss_ += (v[j][0] * v[j][0] + v[j][1] * v[j][1]) + (v[j][2] * v[j][2] + v[j][3] * v[j][3]); \
            const float rs_ = rsqrtf(wave_sum(ss_) * (1.0f / D) + EPS); \
            _Pragma("unroll") for (int j = 0; j < 4; ++j) { const f32x4 o_ = v[j] * am[j] * rs_ + sh[j]; \
                u32x2 w_; w_.x = cvt_pk_bf16(o_[0], o_[1]); w_.y = cvt_pk_bf16(o_[2], o_[3]); *(u32x2*)(HIN + (size_t)(row_) * D + 4 * (lane + 64 * j)) = w_; } } } while (0)
    const int rb = (int)((long)c.gw * TP / c.ngw), re = (int)((long)(c.gw + 1) * TP / c.ngw);
    if (rb < re) {
        NormRow nx[2];
#pragma unroll
        for (int k = 0; k < 2; ++k) { nx[k].p = 0.f;
#pragma unroll
            for (int j = 0; j < 4; ++j) { nx[k].f[j].x = 0u; nx[k].f[j].y = 0u; nx[k].xb[j].x = 0u; nx[k].xb[j].y = 0u; nx[k].v[j] = (f32x4){0.f, 0.f, 0.f, 0.f}; } }
#define NORM_XIN(r_) (xf32 ? GIN(c, 0) + (size_t)(r_) * D : c.out + (size_t)(r_) * D)
        norm_load(nx[0], NORM_XIN(rb), F, PSS, rb, lane, has_upd, xf32);
        if (rb + 1 < re) norm_load(nx[1], NORM_XIN(rb + 1), F, PSS, rb + 1, lane, has_upd, xf32);
        for (int row0 = rb; row0 < re; row0 += 2) {
            NormRow cu[2];
            cu[0] = nx[0]; cu[1] = nx[1];
            if (row0 + 2 < re) norm_load(nx[0], NORM_XIN(row0 + 2), F, PSS, row0 + 2, lane, has_upd, xf32);
            if (row0 + 3 < re) norm_load(nx[1], NORM_XIN(row0 + 3), F, PSS, row0 + 3, lane, has_upd, xf32);
#pragma unroll
            for (int k = 0; k < 2; ++k) {
                const int row = row0 + k;
                if (row < re) {
                    NORM_PARAMS(row >> 12);
                    f32x4 v[4], fv[4]; float rf = 0.f;
#pragma unroll
                    for (int j = 0; j < 4; ++j) { v[j] = xf32 ? cu[k].v[j] : (f32x4){bflo(cu[k].xb[j].x), bfhi(cu[k].xb[j].x), bflo(cu[k].xb[j].y), bfhi(cu[k].xb[j].y)};
                        fv[j] = (f32x4){bflo(cu[k].f[j].x), bfhi(cu[k].f[j].x), bflo(cu[k].f[j].y), bfhi(cu[k].f[j].y)}; }
                    if (has_upd) { float p = cu[k].p; p += __shfl_xor(p, 1); p += __shfl_xor(p, 2); p += __shfl_xor(p, 4); p += __shfl_xor(p, 8); rf = rsqrtf(p * (1.0f / D) + EPS); }
                    NORM_BODY(row, v, fv, rf);
                }
            }
        }
#undef NORM_XIN
    }
    {
        const int nsl = (subp != 1) ? DFF / 256 : (lp == 0 ? DIN / 256 : D / 256);
        const float* obias = (subp == 1 && lp == 1) ? GIN(c, 26) : nullptr;
        const float* PART = (const float*)(c.ws + OFF_PART);
        for (int rs = c.gw; rs < TS; rs += c.ngw) {
            const int row = TP + rs;
            f32x4 v[4], fv[4]; float rf = 0.f;
            if (xf32) {
#pragma unroll
                for (int j = 0; j < 4; ++j) v[j] = *(const f32x4*)(GIN(c, 1) + (size_t)rs * D + 4 * (lane + 64 * j));
            } else {
#pragma unroll
                for (int j = 0; j < 4; ++j) { const u32x2 xb = *(const u32x2*)((const bf16_t*)(c.out + (size_t)row * D) + 4 * (lane + 64 * j)); v[j] = (f32x4){bflo(xb.x), bfhi(xb.x), bflo(xb.y), bfhi(xb.y)}; }
            }
#pragma unroll
            for (int j = 0; j < 4; ++j) fv[j] = (f32x4){0.f, 0.f, 0.f, 0.f};
            if (has_upd) {
#pragma unroll
                for (int j = 0; j < 4; ++j) if (obias) fv[j] = *(const f32x4*)(obias + 4 * (lane + 64 * j));
                for (int k0 = 0; k0 < nsl; k0 += 4) {
                    f32x4 t[4][4];
#pragma unroll
                    for (int kk = 0; kk < 4; ++kk)
#pragma unroll
                        for (int j = 0; j < 4; ++j) t[kk][j] = (k0 + kk < nsl) ? *(const f32x4*)(PART + ((size_t)(k0 + kk) * TS + rs) * D + 4 * (lane + 64 * j)) : (f32x4){0.f, 0.f, 0.f, 0.f};
#pragma unroll
                    for (int kk = 0; kk < 4; ++kk)
#pragma unroll
                        for (int j = 0; j < 4; ++j) fv[j] = fv[j] + t[kk][j];
                }
                float ss = 0.f;
#pragma unroll
                for (int j = 0; j < 4; ++j) ss += (fv[j][0] * fv[j][0] + fv[j][1] * fv[j][1]) + (fv[j][2] * fv[j][2] + fv[j][3] * fv[j][3]);
                rf = rsqrtf(wave_sum(ss) * (1.0f / D) + EPS);
            }
            NORM_PARAMS(8 + (rs >> 3));
            NORM_BODY(row, v, fv, rf);
        }
    }
#undef NORM_PARAMS
#undef NORM_BODY
}

__device__ __forceinline__ void conv_phase(const Ctx& c) {
    bf16_t* XBC = (bf16_t*)(c.ws + OFF_XBC);
    const bf16_t* HALO = (const bf16_t*)(c.ws + OFF_HALO);
    const float* cw = GIN(c, 15); const float* cbias = GIN(c, 16); const float* sconv = GIN(c, 3);
    constexpr int NCONV = NCHUNK * 12, NACS = NCHUNK / 2;
    float* cso = c.dry ? (float*)(c.ws + OFF_HIN) : c.out + O_CONVS; float* cpo = c.dry ? (float*)(c.ws + OFF_HIN) + 2097152 : c.out + O_CONVP;
    for (int it = c.gw; it < NCONV + NACS; it += c.ngw) {
        if (it < NCONV) {
            const int ck = it / 12, sl = it % 12, ch = sl * 256 + c.lane * 4;
            const f32x4 w0 = *(const f32x4*)(cw + ch), w1 = *(const f32x4*)(cw + CONVD + ch), w2 = *(const f32x4*)(cw + 2 * CONVD + ch), w3 = *(const f32x4*)(cw + 3 * CONVD + ch);
            const f32x4 bb = *(const f32x4*)(cbias + ch);
            const bool samp = ck >= 256;
            f32x4 h0 = (f32x4){0.f, 0.f, 0.f, 0.f}, h1 = h0, h2 = h0;
            if (!samp && (ck & 31) != 0) {
                const bf16_t* hp = HALO + (size_t)(ck - 1) * 3 * CONVD + ch;
                const u32x2 a = *(const u32x2*)hp, b = *(const u32x2*)(hp + CONVD), d = *(const u32x2*)(hp + 2 * CONVD);
                h0 = (f32x4){bflo(a.x), bfhi(a.x), bflo(a.y), bfhi(a.y)}; h1 = (f32x4){bflo(b.x), bfhi(b.x), bflo(b.y), bfhi(b.y)}; h2 = (f32x4){bflo(d.x), bfhi(d.x), bflo(d.y), bfhi(d.y)};
            }
            const bool lastp = !samp && (ck & 31) == 31;
            for (int t0 = 0; t0 < 128; t0 += 16) {
                const size_t rbase = (size_t)ck * 128 + t0;
                u32x2 raw[16];
#pragma unroll
                for (int i = 0; i < 16; ++i) raw[i] = *(const u32x2*)(XBC + (rbase + i) * CONVD + ch);
                f32x4 sh[2][3];
                int sq = 0;
                if (samp) {
                    sq = (ck - 256) * 16 + (t0 >> 3);
#pragma unroll
                    for (int hf = 0; hf < 2; ++hf) { const float* sp = sconv + (size_t)(sq + hf) * 3 * CONVD + ch;
                        sh[hf][0] = *(const f32x4*)sp; sh[hf][1] = *(const f32x4*)(sp + CONVD); sh[hf][2] = *(const f32x4*)(sp + 2 * CONVD); }
                }
#pragma unroll
                for (int i = 0; i < 16; ++i) {
                    if (samp && (i & 7) == 0) { h0 = sh[i >> 3][0]; h1 = sh[i >> 3][1]; h2 = sh[i >> 3][2]; }
                    const f32x4 x = (f32x4){bflo(raw[i].x), bfhi(raw[i].x), bflo(raw[i].y), bfhi(raw[i].y)};
                    f32x4 o = w0 * h0 + w1 * h1 + w2 * h2 + w3 * x + bb;
                    o[0] = silu_f(o[0]); o[1] = silu_f(o[1]); o[2] = silu_f(o[2]); o[3] = silu_f(o[3]);
                    u32x2 w; w.x = cvt_pk_bf16(o[0], o[1]); w.y = cvt_pk_bf16(o[2], o[3]);
                    *(u32x2*)(XBC + (rbase + i) * CONVD + ch) = w;
                    if (samp) { if ((i & 7) >= 5) *(f32x4*)(cso + ((size_t)(sq + (i >> 3)) * 3 + ((i & 7) - 5)) * CONVD + ch) = x; }
                    else if (lastp && t0 == 112 && i >= 13) *(f32x4*)(cpo + ((size_t)(ck >> 5) * 3 + (i - 13)) * CONVD + ch) = x;
                    h0 = h1; h1 = h2; h2 = x;
                }
            }
        } else {
            const int ck = (it - NCONV) * 2 + (c.lane >> 5), h = c.lane & 31;
            const float A = -__expf(GIN(c, 18)[h]);
            const float* DTS = (const float*)(c.ws + OFF_DTS); float* ACS = (float*)(c.ws + OFF_ACS);
            const bool samp = ck >= 256;
            float cum = 0.f;
            for (int t0 = 0; t0 < 128; t0 += 8) {
                float d[8];
#pragma unroll
                for (int i = 0; i < 8; ++i) d[i] = DTS[((size_t)ck * 128 + t0 + i) * 32 + h];
                if (samp) cum = 0.f;
#pragma unroll
                for (int i = 0; i < 8; ++i) { cum += d[i] * A; ACS[((size_t)ck * 128 + t0 + i) * 32 + h] = cum; }
            }
        }
    }
}

constexpr int SROW = 272, XROW = 144;
constexpr int SC_C = 0, SC_B = 34816, SC_BS = 69632, SC_X = 104448, SC_H = 122880, SC_F = 140288;
static_assert(SC_F + 1024 <= LDS_BYTES - 64, "scan LDS");
#define MFMA16(a, b, c) __builtin_amdgcn_mfma_f32_16x16x32_bf16((a), (b), (c), 0, 0, 0)
typedef short v4i16_t __attribute__((ext_vector_type(4)));
__device__ __forceinline__ u32x2 tr_read(LAS unsigned char* p) { return __builtin_bit_cast(u32x2, __builtin_amdgcn_ds_read_tr16_b64_v4i16((LAS v4i16_t*)p)); }
__device__ __forceinline__ bf16x8 tr_frag(LAS unsigned char* img, int rs, int kb, int nb, int lane) {
    const int g = lane >> 4, qq = (lane >> 2) & 3, pp = lane & 3;
    LAS unsigned char* a = img + (kb + 8 * g + qq) * rs + (nb + 4 * pp) * 2;
    const u32x2 lo = tr_read(a), hi = tr_read(a + 4 * rs);
    u32x4 v; v.x = lo.x; v.y = lo.y; v.z = hi.x; v.w = hi.y;
    return __builtin_bit_cast(bf16x8, v);
}

__device__ __forceinline__ void scan_prompt_unit(const Ctx& c, int b, int h) {
    LAS unsigned char* lds = c.lds;
    const int tid = c.tid, lane = c.lane, w = c.wave, q = lane >> 4, c16 = lane & 15, g = h >> 3;
    bf16_t* XBC = (bf16_t*)(c.ws + OFF_XBC);
    const float* DTS = (const float*)(c.ws + OFF_DTS); const float* ACS = (const float*)(c.ws + OFF_ACS);
    const float Dh = GIN(c, 19)[h];
    LAS float* acsL = (LAS float*)(lds + SC_F); LAS float* dtL = acsL + 128;
    f32x4 hacc[4];
#pragma unroll
    for (int pt = 0; pt < 4; ++pt) hacc[pt] = (f32x4){0.f, 0.f, 0.f, 0.f};
    for (int i = tid; i < 64 * SROW / 4; i += 512) ((LAS unsigned*)(lds + SC_H))[i] = 0u;
    u32x4 pc[4], pb[4], px[2]; float pdt[4], pac[4], pa_last, pa_mine = 0.f, pd_mine = 0.f;
    const int prow = tid >> 4, pcc = tid & 15, xrow = tid >> 3, xcc = tid & 7;
#define SCAN_LOAD(ck_) do { const size_t r0_ = (size_t)b * PSEQ + (size_t)(ck_) * 128; \
        _Pragma("unroll") for (int i = 0; i < 4; ++i) { const bf16_t* rp = XBC + (r0_ + prow + 32 * i) * CONVD + g * 128 + pcc * 8; pc[i] = *(const u32x4*)(rp + 2560); pb[i] = *(const u32x4*)(rp + 2048); \
            pdt[i] = DTS[(r0_ + prow + 32 * i) * 32 + h]; pac[i] = ACS[(r0_ + prow + 32 * i) * 32 + h]; } \
        _Pragma("unroll") for (int i = 0; i < 2; ++i) px[i] = *(const u32x4*)(XBC + (r0_ + xrow + 64 * i) * CONVD + h * 64 + xcc * 8); \
        pa_last = ACS[(r0_ + 127) * 32 + h]; \
        if (tid < 128) { pa_mine = ACS[(r0_ + tid) * 32 + h]; pd_mine = DTS[(r0_ + tid) * 32 + h]; } } while (0)
    SCAN_LOAD(0);
    __syncthreads();
    for (int ck = 0; ck < 32; ++ck) {
        const size_t r0 = (size_t)b * PSEQ + (size_t)ck * 128;
        asm volatile("s_waitcnt vmcnt(0)" : "+v"(pa_last), "+v"(pa_mine), "+v"(pd_mine), "+v"(pdt[0]), "+v"(pdt[1]), "+v"(pdt[2]), "+v"(pdt[3]), "+v"(pac[0]), "+v"(pac[1]), "+v"(pac[2]), "+v"(pac[3]) :: "memory");
        asm volatile("" : "+v"(pc[0]), "+v"(pc[1]), "+v"(pc[2]), "+v"(pc[3]), "+v"(pb[0]), "+v"(pb[1]), "+v"(pb[2]), "+v"(pb[3]), "+v"(px[0]), "+v"(px[1]));
        const float acs_last = pa_last;
        if (tid < 128) { acsL[tid] = pa_mine; dtL[tid] = pd_mine; }
#pragma unroll
        for (int i = 0; i < 4; ++i) {
            const int row = prow + 32 * i;
            *(LAS u32x4*)(lds + SC_C + row * SROW + pcc * 16) = pc[i];
            *(LAS u32x4*)(lds + SC_B + row * SROW + pcc * 16) = pb[i];
            const float cf = pdt[i] * __expf(acs_last - pac[i]);
            u32x4 sb; sb.x = cvt_pk_bf16(bflo(pb[i].x) * cf, bfhi(pb[i].x) * cf); sb.y = cvt_pk_bf16(bflo(pb[i].y) * cf, bfhi(pb[i].y) * cf);
            sb.z = cvt_pk_bf16(bflo(pb[i].z) * cf, bfhi(pb[i].z) * cf); sb.w = cvt_pk_bf16(bflo(pb[i].w) * cf, bfhi(pb[i].w) * cf);
            *(LAS u32x4*)(lds + SC_BS + row * SROW + pcc * 16) = sb;
        }
#pragma unroll
        for (int i = 0; i < 2; ++i) *(LAS u32x4*)(lds + SC_X + (xrow + 64 * i) * XROW + xcc * 16) = px[i];
        __syncthreads();
        if (ck + 1 < 32) SCAN_LOAD(ck + 1);
        bf16x8 cf[4];
#pragma unroll
        for (int k = 0; k < 4; ++k) cf[k] = *(const LAS bf16x8*)(lds + SC_C + (16 * w + c16) * SROW + (32 * k + 8 * q) * 2);
        f32x4 cb[8];
#pragma unroll
        for (int st = 0; st < 8; ++st) {
            cb[st] = (f32x4){0.f, 0.f, 0.f, 0.f};
            if (st <= w) {
#pragma unroll
                for (int k = 0; k < 4; ++k) { const bf16x8 bf = *(const LAS bf16x8*)(lds + SC_B + (16 * st + c16) * SROW + (32 * k + 8 * q) * 2); cb[st] = MFMA16(bf, cf[k], cb[st]); }
            }
        }
        f32x4 yo[4];
#pragma unroll
        for (int pt = 0; pt < 4; ++pt) {
            yo[pt] = (f32x4){0.f, 0.f, 0.f, 0.f};
#pragma unroll
            for (int k = 0; k < 4; ++k) { const bf16x8 hf = *(const LAS bf16x8*)(lds + SC_H + (16 * pt + c16) * SROW + (32 * k + 8 * q) * 2); yo[pt] = MFMA16(hf, cf[k], yo[pt]); }
        }
        bf16x8 xf[2][4];
        {
            const float cdec = __expf(acs_last);
#pragma unroll
            for (int pt = 0; pt < 4; ++pt) hacc[pt] = hacc[pt] * cdec;
#pragma unroll
            for (int kl = 0; kl < 4; ++kl) {
                const bf16x8 btf = tr_frag(lds + SC_BS, SROW, 32 * kl, 16 * w, lane);
#pragma unroll
                for (int pt = 0; pt < 4; ++pt) {
                    const bf16x8 x_ = tr_frag(lds + SC_X, XROW, 32 * kl, 16 * pt, lane);
                    if (kl < 2) xf[kl][pt] = x_;
                    hacc[pt] = MFMA16(btf, x_, hacc[pt]);
                }
            }
        }
        __syncthreads();
        {
            const int l = 16 * w + c16; const float acs_l = acsL[l];
#pragma unroll
            for (int st = 0; st < 8; ++st) {
                if (st <= (w | 1)) {
                    u32x2 pk; pk.x = 0u; pk.y = 0u;
                    if (st <= w) {
                        const f32x4 as = *(const LAS f32x4*)(acsL + 16 * st + 4 * q), ds = *(const LAS f32x4*)(dtL + 16 * st + 4 * q);
                        float v[4];
#pragma unroll
                        for (int r = 0; r < 4; ++r) { const int s_ = 16 * st + 4 * q + r; const float e = __expf(acs_l - as[r]) * ds[r] * cb[st][r]; v[r] = (s_ <= l) ? e : 0.f; }
                        pk.x = cvt_pk_bf16(v[0], v[1]); pk.y = cvt_pk_bf16(v[2], v[3]);
                    }
                    *(LAS u32x2*)(lds + SC_B + l * SROW + (16 * st + 4 * q) * 2) = pk;
                }
            }
        }
        f32x4 yd[4];
#pragma unroll
        for (int pt = 0; pt < 4; ++pt) yd[pt] = (f32x4){0.f, 0.f, 0.f, 0.f};
#pragma unroll
        for (int ks = 0; ks < 4; ++ks) {
            if (ks <= (w >> 1)) {
                const bf16x8 wf = *(const LAS bf16x8*)(lds + SC_B + (16 * w + c16) * SROW + (32 * ks + 8 * q) * 2);
#pragma unroll
                for (int pt = 0; pt < 4; ++pt) { const bf16x8 x_ = (ks < 2) ? xf[ks & 1][pt] : tr_frag(lds + SC_X, XROW, 32 * ks, 16 * pt, lane); yd[pt] = MFMA16(x_, wf, yd[pt]); }
            }
        }
        {
            const int l = 16 * w + c16;
            const float el = __expf(acsL[l]);
#pragma unroll
            for (int pt = 0; pt < 4; ++pt) {
                const u32x2 xr = *(const LAS u32x2*)(lds + SC_X + l * XROW + (16 * pt + 4 * q) * 2);
                const float y0 = yd[pt][0] + el * yo[pt][0] + Dh * bflo(xr.x), y1 = yd[pt][1] + el * yo[pt][1] + Dh * bfhi(xr.x);
                const float y2 = yd[pt][2] + el * yo[pt][2] + Dh * bflo(xr.y), y3 = yd[pt][3] + el * yo[pt][3] + Dh * bfhi(xr.y);
                u32x2 o; o.x = cvt_pk_bf16(y0, y1); o.y = cvt_pk_bf16(y2, y3);
                *(u32x2*)(XBC + (r0 + l) * CONVD + h * 64 + 16 * pt + 4 * q) = o;
            }
        }
#pragma unroll
        for (int pt = 0; pt < 4; ++pt) { u32x2 pk; pk.x = cvt_pk_bf16(hacc[pt][0], hacc[pt][1]); pk.y = cvt_pk_bf16(hacc[pt][2], hacc[pt][3]);
            *(LAS u32x2*)(lds + SC_H + (16 * pt + c16) * SROW + (16 * w + 4 * q) * 2) = pk; }
        __syncthreads();
    }
#undef SCAN_LOAD
    float* sp = (c.dry ? (float*)(c.ws + OFF_HIN) : c.out + O_SSMP) + (size_t)(b * 32 + h) * 64 * 128;
#pragma unroll
    for (int pt = 0; pt < 4; ++pt) *(f32x4*)(sp + (size_t)(16 * pt + c16) * 128 + 16 * w + 4 * q) = hacc[pt];
}

__device__ __forceinline__ bf16x8 tr_frag8(LAS unsigned char* img, int rs, int nb, int lane) {
    const int qq = (lane >> 2) & 3, pp = lane & 3;
    LAS unsigned char* a = img + qq * rs + (nb + 4 * pp) * 2;
    const u32x2 lo = tr_read(a), hi = tr_read(a + 4 * rs);
    u32x4 v; const bool z = lane >= 16;
    v.x = z ? 0u : lo.x; v.y = z ? 0u : lo.y; v.z = z ? 0u : hi.x; v.w = z ? 0u : hi.y;
    return __builtin_bit_cast(bf16x8, v);
}
__device__ __forceinline__ void scan_sample_wave(const Ctx& c, int bs, int h) {
    constexpr int W_C = 0, W_B = 4352, W_BS = 8704, W_X = 10880, W_F = 12032;
    LAS unsigned char* L = c.lds + c.wave * 16384;
    LAS float* acsL = (LAS float*)(L + W_F); LAS float* dtL = acsL + 8;
    const int lane = c.lane, q = lane >> 4, c16 = lane & 15, g = h >> 3, l8 = lane >> 3, ch = lane & 7;
    bf16_t* XBC = (bf16_t*)(c.ws + OFF_XBC);
    const float* DTS = (const float*)(c.ws + OFF_DTS); const float* ACS = (const float*)(c.ws + OFF_ACS);
    const size_t r0 = (size_t)TP + (size_t)bs * 8;
    const float Dh = GIN(c, 19)[h];
    {
        const bf16_t* rp = XBC + (r0 + l8) * CONVD;
        const u32x4 b0 = *(const u32x4*)(rp + 2048 + g * 128 + ch * 16), b1 = *(const u32x4*)(rp + 2048 + g * 128 + ch * 16 + 8);
        const u32x4 c0 = *(const u32x4*)(rp + 2560 + g * 128 + ch * 16), c1 = *(const u32x4*)(rp + 2560 + g * 128 + ch * 16 + 8);
        const u32x4 xv = *(const u32x4*)(rp + h * 64 + ch * 8);
        const float dtl = DTS[(r0 + l8) * 32 + h], acl = ACS[(r0 + l8) * 32 + h], a7 = ACS[(r0 + 7) * 32 + h];
        const float cf = dtl * __expf(a7 - acl);
        asm volatile("s_waitcnt lgkmcnt(0)" ::: "memory");
        *(LAS u32x4*)(L + W_C + l8 * SROW + ch * 32) = c0; *(LAS u32x4*)(L + W_C + l8 * SROW + ch * 32 + 16) = c1;
        *(LAS u32x4*)(L + W_B + l8 * SROW + ch * 32) = b0; *(LAS u32x4*)(L + W_B + l8 * SROW + ch * 32 + 16) = b1;
        u32x4 s0, s1;
        s0.x = cvt_pk_bf16(bflo(b0.x) * cf, bfhi(b0.x) * cf); s0.y = cvt_pk_bf16(bflo(b0.y) * cf, bfhi(b0.y) * cf); s0.z = cvt_pk_bf16(bflo(b0.z) * cf, bfhi(b0.z) * cf); s0.w = cvt_pk_bf16(bflo(b0.w) * cf, bfhi(b0.w) * cf);
        s1.x = cvt_pk_bf16(bflo(b1.x) * cf, bfhi(b1.x) * cf); s1.y = cvt_pk_bf16(bflo(b1.y) * cf, bfhi(b1.y) * cf); s1.z = cvt_pk_bf16(bflo(b1.z) * cf, bfhi(b1.z) * cf); s1.w = cvt_pk_bf16(bflo(b1.w) * cf, bfhi(b1.w) * cf);
        *(LAS u32x4*)(L + W_BS + l8 * SROW + ch * 32) = s0; *(LAS u32x4*)(L + W_BS + l8 * SROW + ch * 32 + 16) = s1;
        *(LAS u32x4*)(L + W_X + l8 * XROW + ch * 16) = xv;
        if (lane < 8) { acsL[lane] = ACS[(r0 + lane) * 32 + h]; dtL[lane] = DTS[(r0 + lane) * 32 + h]; }
        asm volatile("s_waitcnt lgkmcnt(0)" ::: "memory");
    }
    const float a7 = acsL[7], cdec = __expf(a7);
    bf16x8 wf;
    {
        f32x4 cbt = (f32x4){0.f, 0.f, 0.f, 0.f};
#pragma unroll
        for (int k = 0; k < 4; ++k) {
            const bf16x8 a = *(const LAS bf16x8*)(L + W_B + c16 * SROW + (32 * k + 8 * q) * 2), b = *(const LAS bf16x8*)(L + W_C + c16 * SROW + (32 * k + 8 * q) * 2);
            cbt = MFMA16(a, b, cbt);
        }
        const int l = c16 & 7; const float acs_l = acsL[l];
        float wv[4];
#pragma unroll
        for (int r = 0; r < 4; ++r) { const int s_ = (4 * q + r) & 7; const float e = __expf(acs_l - acsL[s_]) * dtL[s_] * cbt[r]; wv[r] = (q < 2 && c16 < 8 && s_ <= l) ? e : 0.f; }
        const unsigned w0 = cvt_pk_bf16(wv[0], wv[1]), w1 = cvt_pk_bf16(wv[2], wv[3]);
        const unsigned h0_ = __shfl_down(w0, 16), h1_ = __shfl_down(w1, 16);
        u32x4 v; const bool z = lane >= 16;
        v.x = z ? 0u : w0; v.y = z ? 0u : w1; v.z = z ? 0u : h0_; v.w = z ? 0u : h1_;
        wf = __builtin_bit_cast(bf16x8, v);
    }
    float el[4];
#pragma unroll
    for (int r = 0; r < 4; ++r) el[r] = __expf(acsL[(4 * q + r) & 7]);
    const float* h0base = GIN(c, 2) + (size_t)(bs * 32 + h) * 64 * 128;
    float* hobase = (c.dry ? (float*)(c.ws + OFF_Z) : c.out + O_SSMS) + (size_t)(bs * 32 + h) * 64 * 128;
#pragma unroll 1
    for (int pb = 0; pb < 4; ++pb) {
        const int p = 16 * pb + c16;
        f32x4 h0[8];
#pragma unroll
        for (int nt = 0; nt < 8; ++nt) h0[nt] = *(const f32x4*)(h0base + (size_t)p * 128 + 16 * nt + 4 * q);
        const bf16x8 xsf = tr_frag8(L + W_X, XROW, 16 * pb, lane);
        f32x4 yd = MFMA16(wf, xsf, ((f32x4){0.f, 0.f, 0.f, 0.f}));
        f32x4 yo = (f32x4){0.f, 0.f, 0.f, 0.f};
#pragma unroll
        for (int a = 0; a < 4; ++a) {
            const u32x2 clo = *(const LAS u32x2*)(L + W_C + c16 * SROW + (32 * a + 4 * q) * 2), chi = *(const LAS u32x2*)(L + W_C + c16 * SROW + (32 * a + 16 + 4 * q) * 2);
            u32x4 av; av.x = clo.x; av.y = clo.y; av.z = chi.x; av.w = chi.y;
            u32x4 bv; bv.x = cvt_pk_bf16(h0[2 * a][0], h0[2 * a][1]); bv.y = cvt_pk_bf16(h0[2 * a][2], h0[2 * a][3]); bv.z = cvt_pk_bf16(h0[2 * a + 1][0], h0[2 * a + 1][1]); bv.w = cvt_pk_bf16(h0[2 * a + 1][2], h0[2 * a + 1][3]);
            yo = MFMA16(__builtin_bit_cast(bf16x8, av), __builtin_bit_cast(bf16x8, bv), yo);
        }
        {
            const u32x2 xr = tr_read(L + W_X + (4 * (q & 1) + ((lane >> 2) & 3)) * XROW + (16 * pb + 4 * (lane & 3)) * 2);
            const float xs[4] = {bflo(xr.x), bfhi(xr.x), bflo(xr.y), bfhi(xr.y)};
            if (q < 2) {
#pragma unroll
                for (int r = 0; r < 4; ++r) { const float y = yd[r] + el[r] * yo[r] + Dh * xs[r]; XBC[(r0 + 4 * q + r) * CONVD + h * 64 + p] = (bf16_t)f2bf(y); }
            }
        }
#pragma unroll
        for (int nt = 0; nt < 8; ++nt) {
            const bf16x8 bsf = tr_frag8(L + W_BS, SROW, 16 * nt, lane);
            const f32x4 S = MFMA16(bsf, xsf, ((f32x4){0.f, 0.f, 0.f, 0.f}));
            *(f32x4*)(hobase + (size_t)p * 128 + 16 * nt + 4 * q) = h0[nt] * cdec + S;
        }
    }
}
__device__ __forceinline__ void scan_phase(const Ctx& c, int mode) {
    if (mode != 2) for (int u = c.bid; u < 256; u += c.G) scan_prompt_unit(c, u >> 5, u & 31);
    if (mode != 1) for (int u = c.gw; u < 4096; u += c.ngw) scan_sample_wave(c, u >> 5, u & 31);
}

__device__ __forceinline__ void gate_phase(const Ctx& c) {
    const bf16_t* XBC = (const bf16_t*)(c.ws + OFF_XBC); bf16_t* Z = (bf16_t*)(c.ws + OFF_Z);
    const float* nw = GIN(c, 20);
    constexpr int NIT = T * 4, U = 4;
    for (int it0 = c.gw; it0 < NIT; it0 += U * c.ngw) {
        u32x4 yv[U], zv[U];
#pragma unroll
        for (int u = 0; u < U; ++u) {
            const int it = it0 + u * c.ngw;
            if (it < NIT) { const int row = it >> 2, col = (it & 3) * 512 + c.lane * 8;
                yv[u] = *(const u32x4*)(XBC + (size_t)row * CONVD + col); zv[u] = *(const u32x4*)(Z + (size_t)row * DIN + col); }
            else { yv[u] = (u32x4){0u, 0u, 0u, 0u}; zv[u] = yv[u]; }
        }
#pragma unroll
        for (int u = 0; u < U; ++u) {
            const int it = it0 + u * c.ngw;
            if (it < NIT) {
                const int row = it >> 2, col = (it & 3) * 512 + c.lane * 8;
                float y[8] = {bflo(yv[u].x), bfhi(yv[u].x), bflo(yv[u].y), bfhi(yv[u].y), bflo(yv[u].z), bfhi(yv[u].z), bflo(yv[u].w), bfhi(yv[u].w)};
                const float z[8] = {bflo(zv[u].x), bfhi(zv[u].x), bflo(zv[u].y), bfhi(zv[u].y), bflo(zv[u].z), bfhi(zv[u].z), bflo(zv[u].w), bfhi(zv[u].w)};
                float ss = 0.f;
#pragma unroll
                for (int j = 0; j < 8; ++j) { y[j] *= silu_f(z[j]); ss += y[j] * y[j]; }
                const float rs = rsqrtf(wave_sum(ss) * (1.0f / 512.0f) + EPS);
                const f32x4 n0 = *(const f32x4*)(nw + col), n1 = *(const f32x4*)(nw + col + 4);
                u32x4 o; o.x = cvt_pk_bf16(y[0] * rs * n0[0], y[1] * rs * n0[1]); o.y = cvt_pk_bf16(y[2] * rs * n0[2], y[3] * rs * n0[3]);
                o.z = cvt_pk_bf16(y[4] * rs * n1[0], y[5] * rs * n1[1]); o.w = cvt_pk_bf16(y[6] * rs * n1[2], y[7] * rs * n1[3]);
                *(u32x4*)(Z + (size_t)row * DIN + col) = o;
            }
        }
    }
}

constexpr int AT_K = 0, AT_KROW = 144, AT_V = 36864, AT_VROW = 144, AT_BT = 73728;
__device__ __forceinline__ void attn_bias(float (&bm)[9][4], const LAS float* bt, int ci, int q) {
#pragma unroll
    for (int jt = 0; jt < 9; ++jt)
#pragma unroll
        for (int r = 0; r < 4; ++r) { const int dist = 128 + ci - 16 * jt - 4 * q - r; const int dd = dist < 0 ? 0 : (dist > 128 ? 128 : dist); const float v = bt[dd]; bm[jt][r] = (dist >= 0 && dist <= 128) ? v : -INFINITY; }
}
__device__ __forceinline__ void attn_tile(LAS unsigned char* lds, const bf16x8 (&qf)[2], const float (&bm)[9][4], int i0, bool first, float sinkv,
                                          bf16_t* obase  , int nrows, int lane) {
    const int q = lane >> 4, c16 = lane & 15, kt0 = i0 >> 4;
    f32x4 s[9];
#pragma unroll
    for (int jt = 0; jt < 9; ++jt) {
        s[jt] = (f32x4){0.f, 0.f, 0.f, 0.f};
#pragma unroll
        for (int k = 0; k < 2; ++k) { const bf16x8 kf = *(const LAS bf16x8*)(lds + AT_K + (16 * (kt0 + jt) + c16) * AT_KROW + (32 * k + 8 * q) * 2); s[jt] = MFMA16(kf, qf[k], s[jt]); }
    }
    float mx = -INFINITY;
#pragma unroll
    for (int jt = 0; jt < 9; ++jt)
#pragma unroll
        for (int r = 0; r < 4; ++r) {
            float x = s[jt][r] * 0.125f + bm[jt][r];
            if (first) { const int j = 16 * (kt0 + jt) + 4 * q + r; x = (j >= 128) ? x : -INFINITY; }
            s[jt][r] = x; mx = fmaxf(mx, x);
        }
    mx = fmaxf(mx, __shfl_xor(mx, 16)); mx = fmaxf(mx, __shfl_xor(mx, 32)); mx = fmaxf(mx, sinkv);
    float sum = 0.f;
#pragma unroll
    for (int jt = 0; jt < 9; ++jt)
#pragma unroll
        for (int r = 0; r < 4; ++r) { const float e = __expf(s[jt][r] - mx); s[jt][r] = e; sum += e; }
    sum += __shfl_xor(sum, 16); sum += __shfl_xor(sum, 32);
    sum += __expf(sinkv - mx);
    const float inv = 1.0f / sum;
    f32x4 o[4];
#pragma unroll
    for (int dt = 0; dt < 4; ++dt) o[dt] = (f32x4){0.f, 0.f, 0.f, 0.f};
#pragma unroll
    for (int a = 0; a < 5; ++a) {
        u32x4 pw; pw.x = cvt_pk_bf16(s[2 * a][0] * inv, s[2 * a][1] * inv); pw.y = cvt_pk_bf16(s[2 * a][2] * inv, s[2 * a][3] * inv);
        if (a < 4) { pw.z = cvt_pk_bf16(s[2 * a + 1][0] * inv, s[2 * a + 1][1] * inv); pw.w = cvt_pk_bf16(s[2 * a + 1][2] * inv, s[2 * a + 1][3] * inv); } else { pw.z = 0u; pw.w = 0u; }
        const bf16x8 pa = __builtin_bit_cast(bf16x8, pw);
#pragma unroll
        for (int dt = 0; dt < 4; ++dt) {
            LAS unsigned char* vb = lds + AT_V + (16 * (kt0 + 2 * a) + 4 * q + ((lane >> 2) & 3)) * AT_VROW + (16 * dt + 4 * (lane & 3)) * 2;
            const u32x2 lo = tr_read(vb);
            u32x2 hi; hi.x = 0u; hi.y = 0u;
            if (a < 4) hi = tr_read(vb + 16 * AT_VROW);
            u32x4 vw; vw.x = lo.x; vw.y = lo.y; vw.z = hi.x; vw.w = hi.y;
            o[dt] = MFMA16(__builtin_bit_cast(bf16x8, vw), pa, o[dt]);
        }
    }
    if (c16 < nrows) {
#pragma unroll
        for (int dt = 0; dt < 4; ++dt) { u32x2 w; w.x = cvt_pk_bf16(o[dt][0], o[dt][1]); w.y = cvt_pk_bf16(o[dt][2], o[dt][3]);
            *(u32x2*)(obase + (size_t)(i0 + c16) * D + 16 * dt + 4 * q) = w; }
    }
}

__device__ __forceinline__ void qkv_sample8(const float* PQ, const float* bias, int rs, int col, f32x4& a, f32x4& b) {
    a = *(const f32x4*)(bias + col); b = *(const f32x4*)(bias + col + 4);
#pragma unroll
    for (int k = 0; k < 4; ++k) { const float* p_ = PQ + ((size_t)k * TS + rs) * QKVD + col; a = a + *(const f32x4*)p_; b = b + *(const f32x4*)(p_ + 4); }
}
__device__ __forceinline__ u32x4 pack8(const f32x4& a, const f32x4& b) { u32x4 w; w.x = cvt_pk_bf16(a[0], a[1]); w.y = cvt_pk_bf16(a[2], a[3]); w.z = cvt_pk_bf16(b[0], b[1]); w.w = cvt_pk_bf16(b[2], b[3]); return w; }
__device__ __forceinline__ void attn_phase(const Ctx& c, int mode) {
    LAS unsigned char* lds = c.lds;
    const int tid = c.tid, w = c.wave;
    const bf16_t* QKV = (const bf16_t*)(c.ws + OFF_QKV); bf16_t* AO = (bf16_t*)(c.ws + OFF_AO);
    const float* rel = GIN(c, 27); const float* sinks = GIN(c, 24);
    const float* PQ = (const float*)(c.ws + OFF_PART); const float* qb_ = GIN(c, 23);
    for (int idx = tid; idx < 16 * 129; idx += 512) {
        const int h = idx / 129, d = idx % 129;
        int bk = d;
        if (d >= 16) { int lg = 16 + (int)(logf((float)d / 16.0f) / 2.0794415416798357f * 16.0f); bk = lg < 31 ? lg : 31; }
        ((LAS float*)(lds + AT_BT))[h * 132 + d] = rel[bk * 16 + h];
    }
    __syncthreads();
    for (int u = c.bid; u < (mode == 2 ? 0 : 1024); u += c.G) {
        const int b = u >> 7, qb = (u >> 2) & 31, g = u & 3;
        const size_t krow0 = (size_t)b * PSEQ + (size_t)qb * 128 - 128;
#pragma unroll
        for (int i = 0; i < 4; ++i) {
            const int idx = tid + 512 * i, j = idx >> 3, cc = idx & 7;
            u32x4 kv = (u32x4){0u, 0u, 0u, 0u}, vv = kv;
            if (qb > 0 || j >= 128) { const bf16_t* rp = QKV + (krow0 + j) * QKVD + g * 64 + cc * 8; kv = *(const u32x4*)(rp + 1024); vv = *(const u32x4*)(rp + 1280); }
            *(LAS u32x4*)(lds + AT_K + j * AT_KROW + cc * 16) = kv;
            *(LAS u32x4*)(lds + AT_V + j * AT_VROW + cc * 16) = vv;
        }
        const int hh = 4 * g + (w >> 1);
        const float sinkv = sinks[hh];
        const size_t qrow0 = (size_t)b * PSEQ + (size_t)qb * 128;
        const int lq = c.lane >> 4, lc = c.lane & 15;
        const bf16_t* qp = QKV + (qrow0 + (w & 1) * 64 + lc) * QKVD + hh * 64 + 8 * lq;
        bf16x8 qn[2];
#pragma unroll
        for (int k = 0; k < 2; ++k) qn[k] = *(const bf16x8*)(qp + 32 * k);
        float bm[9][4];
        attn_bias(bm, (const LAS float*)(lds + AT_BT) + hh * 132, lc, lq);
        __syncthreads();
#pragma unroll 1
        for (int ti = 0; ti < (mode == 3 ? 0 : 4); ++ti) {
            bf16x8 qc[2]; qc[0] = qn[0]; qc[1] = qn[1];
            if (ti + 1 < 4) {
#pragma unroll
                for (int k = 0; k < 2; ++k) qn[k] = *(const bf16x8*)(qp + (size_t)(16 * (ti + 1)) * QKVD + 32 * k);
            }
            attn_tile(lds, qc, bm, (w & 1) * 64 + 16 * ti, qb == 0, sinkv, AO + qrow0 * D + hh * 64, 16, c.lane);
        }
        __syncthreads();
    }
    const float* ck = GIN(c, 4); const float* cv = GIN(c, 5);
    for (int u = c.bid; u < ((mode == 1 || mode == 3) ? 0 : 512); u += c.G) {
        const int bs = u >> 2, g = u & 3;
        for (int idx = tid; idx < 144 * 8; idx += 512) {
            const int j = idx >> 3, cc = idx & 7;
            u32x4 kv = (u32x4){0u, 0u, 0u, 0u}, vv = kv;
            if (j < 128) {
                const float* kp = ck + (((size_t)bs * 128 + j) * 4 + g) * 64 + cc * 8; const float* vp = cv + (((size_t)bs * 128 + j) * 4 + g) * 64 + cc * 8;
                const f32x4 k0 = *(const f32x4*)kp, k1 = *(const f32x4*)(kp + 4), v0 = *(const f32x4*)vp, v1 = *(const f32x4*)(vp + 4);
                kv.x = pk2(k0[0], k0[1]); kv.y = pk2(k0[2], k0[3]); kv.z = pk2(k1[0], k1[1]); kv.w = pk2(k1[2], k1[3]);
                vv.x = pk2(v0[0], v0[1]); vv.y = pk2(v0[2], v0[3]); vv.z = pk2(v1[0], v1[1]); vv.w = pk2(v1[2], v1[3]);
            } else if (j < 136) {
                f32x4 a_, b_; const int rs_ = bs * 8 + (j - 128);
                qkv_sample8(PQ, qb_, rs_, 1024 + g * 64 + cc * 8, a_, b_); kv = pack8(a_, b_);
                qkv_sample8(PQ, qb_, rs_, 1280 + g * 64 + cc * 8, a_, b_); vv = pack8(a_, b_);
            }
            *(LAS u32x4*)(lds + AT_K + j * AT_KROW + cc * 16) = kv;
            *(LAS u32x4*)(lds + AT_V + j * AT_VROW + cc * 16) = vv;
        }
        __syncthreads();
        if (w < 4) {
            const int hh = 4 * g + w;
            const size_t qrow0 = (size_t)TP + (size_t)bs * 8;
            const int lq = c.lane >> 4, lc = c.lane & 7;
            bf16x8 qf[2];
#pragma unroll
            for (int k = 0; k < 2; ++k) { f32x4 a_, b_; qkv_sample8(PQ, qb_, bs * 8 + lc, hh * 64 + 32 * k + 8 * lq, a_, b_); qf[k] = __builtin_bit_cast(bf16x8, pack8(a_, b_)); }
            float bm[9][4];
            attn_bias(bm, (const LAS float*)(lds + AT_BT) + hh * 132, lc, lq);
            attn_tile(lds, qf, bm, 0, false, sinks[hh], AO + qrow0 * D + hh * 64, 8, c.lane);
        }
        __syncthreads();
    }
    if (c.dry) return;
    const int gt = c.bid * 512 + tid, ngt = c.G * 512;
    for (int idx = gt; idx < 8 * 128 * 64; idx += ngt) {
        const int b = idx >> 13, jj = (idx >> 6) & 127, cc = (idx & 63) * 4;
        const bf16_t* rp = QKV + ((size_t)b * PSEQ + 3968 + jj) * QKVD + cc;
        const u32x2 kw = *(const u32x2*)(rp + 1024), vw = *(const u32x2*)(rp + 1280);
        *(f32x4*)(c.out + O_KP + (size_t)idx * 4) = (f32x4){bflo(kw.x), bfhi(kw.x), bflo(kw.y), bfhi(kw.y)};
        *(f32x4*)(c.out + O_VP + (size_t)idx * 4) = (f32x4){bflo(vw.x), bfhi(vw.x), bflo(vw.y), bfhi(vw.y)};
    }
    for (int idx = gt; idx < 128 * 128 * 64; idx += ngt) {
        const int b = idx >> 13, jj = (idx >> 6) & 127, cc = (idx & 63) * 4;
        f32x4 kx, vx;
        if (jj < 120) { kx = *(const f32x4*)(ck + ((size_t)b * 128 + jj + 8) * 256 + cc); vx = *(const f32x4*)(cv + ((size_t)b * 128 + jj + 8) * 256 + cc); }
        else { const int rs_ = b * 8 + (jj - 120);
            kx = *(const f32x4*)(qb_ + 1024 + cc); vx = *(const f32x4*)(qb_ + 1280 + cc);
#pragma unroll
            for (int k = 0; k < 4; ++k) { const float* p_ = PQ + ((size_t)k * TS + rs_) * QKVD + cc; kx = kx + *(const f32x4*)(p_ + 1024); vx = vx + *(const f32x4*)(p_ + 1280); } }
        *(f32x4*)(c.out + O_KS + (size_t)idx * 4) = kx; *(f32x4*)(c.out + O_VS + (size_t)idx * 4) = vx;
    }
}


#define XB_TMO      128
#define XB_XCNT(j)  (256  + 64 * (j))
#define XB_XSUB(j)  (1280 + 64 * (j))
#define XB_XGEN(j)  (2304 + 64 * (j))
#define XB_TOP      3328
#define XB_TOPGEN   3392
#define XCD_BAR_WORDS 3456
#define XB_SPIN_CAP (1u << 18)
__device__ __forceinline__ unsigned xb_ld(unsigned* p)              { return __hip_atomic_load(p, __ATOMIC_RELAXED, __HIP_MEMORY_SCOPE_AGENT); }
__device__ __forceinline__ unsigned xb_add(unsigned* p, unsigned v) { return __hip_atomic_fetch_add(p, v, __ATOMIC_RELAXED, __HIP_MEMORY_SCOPE_AGENT); }
__device__ __forceinline__ unsigned xb_xcc_id() { return (unsigned)__builtin_amdgcn_s_getreg((3 << 11) | 20) & 0xFu; }
#define XB_SPIN(cond, bar) do { unsigned _sp = 0; while (cond) { __builtin_amdgcn_s_sleep(1); \
    if ((++_sp & 255u) == 0u) { if (xb_ld(&(bar)[XB_TMO])) break; if (_sp > XB_SPIN_CAP) { atomicAdd(&(bar)[XB_TMO], 1u); break; } } } } while (0)
struct XcdBarrier { unsigned* bar; unsigned x; volatile LAS unsigned* st; };
__device__ __forceinline__ XcdBarrier xcd_barrier_post(unsigned* bar, volatile LAS unsigned* st) {
    XcdBarrier b; b.bar = bar; b.x = xb_xcc_id(); b.st = st;
    if (threadIdx.x == 0) (void)xb_add(&bar[XB_XCNT(b.x)], 1u);
    return b;
}
__device__ __forceinline__ void xcd_barrier_complete(unsigned* bar, unsigned x, unsigned& nloc, unsigned& nx) {
    const unsigned G = gridDim.x * gridDim.y * gridDim.z;
    unsigned sum, cnt, mine, sp = 0u;
    for (;;) {
        sum = 0u; cnt = 0u; mine = 0u;
#pragma unroll
        for (unsigned j = 0; j < 16; ++j) { const unsigned c = xb_ld(&bar[XB_XCNT(j)]); sum += c; cnt += (c > 0u) ? 1u : 0u; mine = (j == x) ? c : mine; }
        if (sum == G) break;
        __builtin_amdgcn_s_sleep(1);
        if ((++sp & 255u) == 0u) { if (xb_ld(&bar[XB_TMO])) break; if (sp > XB_SPIN_CAP) { atomicAdd(&bar[XB_TMO], 1u); break; } }
    }
    nloc = mine > 0u ? mine : 1u; nx = cnt > 0u ? cnt : 1u;
}
__device__ __forceinline__ void xcd_barrier(const XcdBarrier& b) {
    asm volatile("s_waitcnt vmcnt(0)" ::: "memory");
    __syncthreads();
    if (threadIdx.x == 0) {
        unsigned* bar = b.bar;
        __builtin_amdgcn_s_waitcnt(0);
        unsigned nloc = b.st[0], nx = b.st[1];
        if (nloc == 0u) { xcd_barrier_complete(bar, b.x, nloc, nx); b.st[0] = nloc; b.st[1] = nx; }
        const unsigned old = xb_add(&bar[XB_XSUB(b.x)], 1u);
        const unsigned gen = old / nloc;
        if (old + 1u == (gen + 1u) * nloc) {
            __builtin_amdgcn_fence(__ATOMIC_RELEASE, "agent");
            asm volatile("s_waitcnt vmcnt(0)" ::: "memory");
            const unsigned og = xb_add(&bar[XB_TOP], 1u);
            const unsigned tg = og / nx;
            if (og + 1u == (tg + 1u) * nx) xb_add(&bar[XB_TOPGEN], 1u);
            else XB_SPIN(xb_ld(&bar[XB_TOPGEN]) == tg, bar);
            __builtin_amdgcn_fence(__ATOMIC_ACQUIRE, "agent");
            xb_add(&bar[XB_XGEN(b.x)], 1u);
            asm volatile("s_waitcnt vmcnt(0)" ::: "memory");
        } else {
            XB_SPIN(xb_ld(&bar[XB_XGEN(b.x)]) == gen, bar);
            __builtin_amdgcn_fence(__ATOMIC_ACQUIRE, "agent");
            asm volatile("s_waitcnt vmcnt(0)" ::: "memory");
        }
    }
    __syncthreads();
}


#ifndef MFMA16
#define MFMA16(a, b, c) __builtin_amdgcn_mfma_f32_16x16x32_bf16((a), (b), (c), 0, 0, 0)
#endif
template <int MODE>
__device__ __forceinline__ void small_gemm_tile(const Ctx& c, const bf16_t* A, const bf16_t* Bt, int K, int tm, int tn, bf16_t* O, int ldo, const float* bias, float* pss) {
    LAS float* P = (LAS float*)c.lds;
    const int lane = c.lane, w = c.wave, q = lane >> 4, c16 = lane & 15;
    const int kw = K >> 3, nks = kw >> 5;
    f32x4 acc[4][4];
#pragma unroll
    for (int mt = 0; mt < 4; ++mt)
#pragma unroll
        for (int nt = 0; nt < 4; ++nt) acc[mt][nt] = (f32x4){0.f, 0.f, 0.f, 0.f};
    const bf16_t* ap = A + (size_t)(64 * tm + c16) * K + w * kw + 8 * q;
    const bf16_t* bp = Bt + (size_t)(64 * tn + c16) * K + w * kw + 8 * q;
#pragma unroll 4
    for (int ks = 0; ks < nks; ++ks) {
        bf16x8 af[4], bfr[4];
#pragma unroll
        for (int mt = 0; mt < 4; ++mt) af[mt] = *(const bf16x8*)(ap + (size_t)mt * 16 * K + ks * 32);
#pragma unroll
        for (int nt = 0; nt < 4; ++nt) bfr[nt] = *(const bf16x8*)(bp + (size_t)nt * 16 * K + ks * 32);
#pragma unroll
        for (int mt = 0; mt < 4; ++mt)
#pragma unroll
            for (int nt = 0; nt < 4; ++nt) acc[mt][nt] = MFMA16(af[mt], bfr[nt], acc[mt][nt]);
    }
#pragma unroll
    for (int mt = 0; mt < 4; ++mt)
#pragma unroll
        for (int nt = 0; nt < 4; ++nt)
#pragma unroll
            for (int r = 0; r < 4; ++r) P[(w * 64 + mt * 16 + 4 * q + r) * 65 + nt * 16 + c16] = acc[mt][nt][r];
    __syncthreads();
    {
        const int row = 8 * w + (lane >> 3), col0 = (lane & 7) * 8;
        float v[8];
#pragma unroll
        for (int j = 0; j < 8; ++j) v[j] = bias ? bias[64 * tn + col0 + j] : 0.f;
#pragma unroll
        for (int ww = 0; ww < 8; ++ww)
#pragma unroll
            for (int j = 0; j < 8; ++j) v[j] += P[(ww * 64 + row) * 65 + col0 + j];
        u32x4 o; o.x = cvt_pk_bf16(v[0], v[1]); o.y = cvt_pk_bf16(v[2], v[3]); o.z = cvt_pk_bf16(v[4], v[5]); o.w = cvt_pk_bf16(v[6], v[7]);
        *(u32x4*)(O + (size_t)(64 * tm + row) * ldo + 64 * tn + col0) = o;
        if (MODE == 0) {
            float ss = 0.f;
#pragma unroll
            for (int j = 0; j < 8; ++j) ss += v[j] * v[j];
            ss += __shfl_xor(ss, 1); ss += __shfl_xor(ss, 2); ss += __shfl_xor(ss, 4);
            if ((lane & 7) == 0) pss[(size_t)(64 * tm + row) * 16 + tn] = ss;
        }
    }
    __syncthreads();
}

enum { ST_P0, ST_GMOD, ST_NORM, ST_GSWI, ST_GROWS_FFN, ST_GINPROJ, ST_CONV, ST_SCAN, ST_GATE, ST_GROWS_SSM, ST_GQKV, ST_ATTN, ST_GROWS_O, ST_NOP, ST_GSLICE };
constexpr int NREAL = 25;
#ifndef GMASK
#define GMASK 0x1FFF
#endif
#ifndef NEXTRA
#define NEXTRA 0
#endif
#ifndef EXTRA_T
#define EXTRA_T
#define EXTRA_A
#endif
constexpr int NSTEPS = NREAL + NEXTRA;
__device__ const unsigned char PROG_T[NSTEPS] = { ST_P0, ST_GMOD,
    ST_NORM, ST_GSWI, ST_GROWS_FFN, ST_NORM, ST_GINPROJ, ST_CONV, ST_SCAN, ST_GATE, ST_GROWS_SSM, ST_NORM, ST_GSWI, ST_GROWS_FFN,
    ST_NORM, ST_GSWI, ST_GROWS_FFN, ST_NORM, ST_GQKV, ST_ATTN, ST_GROWS_O, ST_NORM, ST_GSWI, ST_GROWS_FFN, ST_NORM EXTRA_T };
__device__ const unsigned char PROG_A[NSTEPS] = { 0, 0,
    0, 0, 0, 1, 0, 0, 0, 0, 0, 2, 1, 1,
    3, 2, 2, 4, 0, 0, 0, 5, 3, 3, 6 EXTRA_A };

__global__ void __launch_bounds__(512, 2) hybrid_fwd(Args args) {
    extern __shared__ __attribute__((aligned(16))) unsigned char lds_raw[];
    cg::grid_group grid = cg::this_grid();
    {
        volatile LAS unsigned* st0 = (volatile LAS unsigned*)((LAS unsigned char*)lds_raw + LDS_BYTES - 64);
        if (threadIdx.x < 2) st0[threadIdx.x] = 0u;
        __syncthreads();
    }
    const XcdBarrier xbar = xcd_barrier_post((unsigned*)(GAS unsigned*)(args.ws + OFF_CTL), (volatile LAS unsigned*)((LAS unsigned char*)lds_raw + LDS_BYTES - 64));
    for (int st = 0; st < NSTEPS; ++st) {
        int tid_o = threadIdx.x; asm volatile("" : "+v"(tid_o));
        GAS unsigned char* ws1 = (GAS unsigned char*)args.ws; asm volatile("" : "+s"(ws1));
        GAS float* out1 = (GAS float*)args.out; asm volatile("" : "+s"(out1));
        unsigned char* ws_g = (unsigned char*)ws1; float* out_g = (float*)out1;
        unsigned char* ws_f = args.ws; asm volatile("" : "+s"(ws_f));
        float* out_f = args.out; asm volatile("" : "+s"(out_f));
        unsigned char* ws = ws_f; float* outp = out_f;
#define PHSEL(bit) do { if ((GMASK >> (bit)) & 1) { c.ws = ws_g; c.out = out_g; ws = ws_g; } else { c.ws = ws_f; c.out = out_f; ws = ws_f; } } while (0)
        Ctx c;
        c.lds = (LAS unsigned char*)lds_raw;
        c.tid = tid_o; c.lane = c.tid & 63; c.wave = __builtin_amdgcn_readfirstlane(c.tid >> 6);
        c.G = gridDim.x; c.bid = blockIdx.x; c.gw = c.bid * NWAVES + c.wave; c.ngw = c.G * NWAVES;
        c.in = args.in; c.out = outp; c.ws = ws; c.dry = st >= NREAL; c.out2 = out_f; c.ws2 = ws_f;
        const int ty = PROG_T[st], arg = PROG_A[st];
        switch (ty) {
        case ST_P0: PHSEL(ST_P0); p0_phase(c); break;
        case ST_GMOD: PHSEL(ST_GMOD); {
            pg8::Gemm g{(const bf16_t*)(ws + OFF_CS), (const bf16_t*)(ws + OFF_ADAT), 256, 18432, 1024};
            pg8::StaticOrder S; S.init(256, 18432, c.G, c.bid);
            EpiMod E{(float*)(ws + OFF_MOD), ((const float*)(const GAS float*)args.in[9])};
            pg8::gemm_phase<EpiMod, pg8::StaticOrder, true, true>(c.lds, g, S, E, c.tid);
            if (c.bid >= 72) p0_run(c, 20480, 1408, 26112, 3712, 0, 0, (c.bid - 72) * NWAVES + c.wave, (c.G - 72) * NWAVES);
        } break;
        case ST_NORM: PHSEL(ST_NORM); norm_phase(c, arg); break;
        case ST_GSWI: PHSEL(ST_GSWI); {
            pg8::Gemm g{(const bf16_t*)(ws + OFF_HIN), (const bf16_t*)(ws + OFF_WIN) + (size_t)arg * NFF2 * D, T, NFF2, D};
            pg8::StaticOrder S; S.init(T, NFF2, c.G, c.bid);
            EpiSwiglu E{(bf16_t*)(ws + OFF_ACT)};
            pg8::gemm_phase<EpiSwiglu, pg8::StaticOrder, true, true>(c.lds, g, S, E, c.tid);
            if (arg < 3 && c.bid >= 88 && !c.dry) {
                const int vw = (c.bid - 88) * NWAVES + c.wave, nvw = (c.G - 88) * NWAVES;
                if (arg == 0) p0_run(c, 12032, 2816, 21888, 1408, 0, 0, vw, nvw);
                else if (arg == 1) p0_run(c, 14848, 2816, 23296, 1408, 29824, 1280, vw, nvw);
                else p0_run(c, 17664, 2816, 24704, 1408, 0, 0, vw, nvw);
            }
        } break;
        case ST_GROWS_FFN: case ST_GROWS_SSM: case ST_GROWS_O: { PHSEL(ST_GROWS_FFN);
            const bf16_t* A0; const bf16_t* B0; int K0; const float* bias = nullptr;
            if (ty == ST_GROWS_FFN) { A0 = (const bf16_t*)(ws + OFF_ACT); B0 = (const bf16_t*)(ws + OFF_WOUT) + (size_t)arg * D * DFF; K0 = DFF; }
            else if (ty == ST_GROWS_SSM) { A0 = (const bf16_t*)(ws + OFF_Z); B0 = (const bf16_t*)(ws + OFF_SSMOUT); K0 = DIN; }
            else { A0 = (const bf16_t*)(ws + OFF_AO); B0 = (const bf16_t*)(ws + OFF_OW); K0 = D; bias = ((const float*)(const GAS float*)args.in[26]); }
#pragma unroll 1
            for (int pass = 0; pass < 2; ++pass) {
                pg8::Gemm g; pg8::StaticOrder S; float* part = nullptr;
                if (pass == 0) { const int pk = c.bid >> 4;
                    g = pg8::Gemm{A0 + (size_t)TP * K0 + (size_t)pk * 256, B0 + (size_t)pk * 256, TS, D, K0, 256};
                    S.init_slices(K0 / 256, c.G, c.bid); part = (float*)(ws + OFF_PART) + (size_t)pk * TS * D; }
                else { g = pg8::Gemm{A0, B0, TP, D, K0, 0}; S.init(TP, D, c.G, c.bid); }
                EpiRows E{(bf16_t*)(ws + OFF_F), bias, (float*)(ws + OFF_PSS), part};
                pg8::gemm_phase<EpiRows, pg8::StaticOrder, true, true>(c.lds, g, S, E, c.tid);
            }
        } break;
        case ST_GINPROJ: PHSEL(ST_GINPROJ); {
            pg8::Gemm g{(const bf16_t*)(ws + OFF_HIN), (const bf16_t*)(ws + OFF_SSMIN), T, NINP, D};
            pg8::StaticOrder S; S.init(T, NINP, c.G, c.bid);
            EpiInproj E{(bf16_t*)(ws + OFF_Z), (bf16_t*)(ws + OFF_XBC), (bf16_t*)(ws + OFF_HALO), (float*)(ws + OFF_DTS), ((const float*)(const GAS float*)args.in[17])};
            pg8::gemm_phase<EpiInproj, pg8::StaticOrder, true, true>(c.lds, g, S, E, c.tid);
        } break;
        case ST_CONV: PHSEL(ST_CONV); conv_phase(c); break;
        case ST_SCAN: PHSEL(ST_SCAN); scan_phase(c, arg); break;
        case ST_GATE: PHSEL(ST_GATE); gate_phase(c); break;
        case ST_GQKV: PHSEL(ST_GQKV); {
#pragma unroll 1
            for (int pass = 0; pass < 2; ++pass) {
                pg8::Gemm g; pg8::StaticOrder S; float* part = nullptr;
                if (pass == 0) { const int pk = c.bid / 24;
                    g = pg8::Gemm{(const bf16_t*)(ws + OFF_HIN) + (size_t)TP * D + (size_t)pk * 256, (const bf16_t*)(ws + OFF_QKVW) + (size_t)pk * 256, TS, QKVD, D, 256};
                    S.init_slices(4, c.G, c.bid, 6); part = (float*)(ws + OFF_PART) + (size_t)pk * TS * QKVD; }
                else { g = pg8::Gemm{(const bf16_t*)(ws + OFF_HIN), (const bf16_t*)(ws + OFF_QKVW), TP, QKVD, D, 0}; S.init(TP, QKVD, c.G, c.bid); }
                EpiQkv E{(bf16_t*)(ws + OFF_QKV), ((const float*)(const GAS float*)args.in[23]), part};
                pg8::gemm_phase<EpiQkv, pg8::StaticOrder, true, true>(c.lds, g, S, E, c.tid);
            }
        } break;
        case ST_ATTN: PHSEL(ST_ATTN); attn_phase(c, arg); break;
        default: break;
        }
        if (st + 1 < NSTEPS) { if (st == 0) grid.sync(); else xcd_barrier(xbar); }
    }
}

extern "C" void kernel_launch(void* const* d_in, const int* in_sizes, int n_in, void* d_out, int out_size, void* d_ws, size_t ws_size, hipStream_t stream) {
    static int grid = 0;
    if (grid == 0) {
        if (n_in != 28 || ws_size < WS_NEED) { fprintf(stderr, "kernel_launch: unexpected n_in %d or ws_size %zu (need %zu)\n", n_in, ws_size, (size_t)WS_NEED); grid = -1; return; }
        int dev = 0, cus = 0, per_cu = 0;
        hipGetDevice(&dev);
        hipDeviceGetAttribute(&cus, hipDeviceAttributeMultiprocessorCount, dev);
        if (hipFuncSetAttribute((const void*)hybrid_fwd, hipFuncAttributeMaxDynamicSharedMemorySize, LDS_BYTES) != hipSuccess) { fprintf(stderr, "kernel_launch: hipFuncSetAttribute failed\n"); grid = -1; return; }
        if (hipOccupancyMaxActiveBlocksPerMultiprocessor(&per_cu, (const void*)hybrid_fwd, 512, LDS_BYTES) != hipSuccess || per_cu < 1) { fprintf(stderr, "kernel_launch: occupancy query gave %d\n", per_cu); per_cu = 1; }
        (void)hipGetLastError();
        grid = cus * (per_cu > 1 ? 1 : per_cu);
    }
    if (grid < 0) return;
    Args a{};
    for (int i = 0; i < 28; ++i) a.in[i] = (const float*)d_in[i];
    a.out = (float*)d_out; a.ws = (unsigned char*)d_ws;
    if (hipMemsetAsync((char*)d_ws + OFF_CTL, 0, CTL_BYTES, stream) != hipSuccess) { fprintf(stderr, "kernel_launch: memset failed\n"); return; }
    void* kargs[] = {&a};
    hipError_t e = hipLaunchCooperativeKernel((const void*)hybrid_fwd, dim3(grid), dim3(512), kargs, LDS_BYTES, stream);
    if (e != hipSuccess) fprintf(stderr, "kernel_launch: cooperative launch failed: %s (grid %d)\n", hipGetErrorString(e), grid);
}
```

```cpp
#include <hip/hip_runtime.h>
#include <hip/hip_cooperative_groups.h>
#include <cstdio>
#include <cstdint>
namespace cg = cooperative_groups;

#define LAS __attribute__((address_space(3)))
#define GAS __attribute__((address_space(1)))
#define GIN(c_, i_) ((const float*)(const GAS float*)((c_).in[i_]))
typedef unsigned short bf16_t;
typedef short bf16x8 __attribute__((ext_vector_type(8)));
typedef float f32x4 __attribute__((ext_vector_type(4)));
typedef float f32x2 __attribute__((ext_vector_type(2)));
typedef unsigned u32x4 __attribute__((ext_vector_type(4)));
typedef unsigned u32x2 __attribute__((ext_vector_type(2)));

constexpr int D = 1024, TP = 32768, TS = 1024, T = TP + TS, NSEQ = 136, PSEQ = 4096, SSEQ = 8;
constexpr int DFF = 2816, NFF2 = 5632;
constexpr int DIN = 2048, CONVD = 3072, NH = 32, NINP = 5376, NIN_REAL = 5152;
constexpr int QKVD = 1536;
constexpr float EPS = 1e-6f;
constexpr int NCHUNK = T / 128;

constexpr size_t OFF_CTL = 0, CTL_BYTES = 16384;
constexpr size_t OFF_CS = CTL_BYTES;
constexpr size_t OFF_MOD = OFF_CS + 256 * 1024 * 2;
constexpr size_t OFF_PSS = OFF_MOD + (size_t)2 * NSEQ * 9216 * 4;
constexpr size_t OFF_DTS = OFF_PSS + (size_t)T * 16 * 4;
constexpr size_t OFF_ACS = OFF_DTS + (size_t)T * 32 * 4;
constexpr size_t OFF_HALO = OFF_ACS + (size_t)T * 32 * 4;
constexpr size_t OFF_WIN = OFF_HALO + (size_t)NCHUNK * 3 * CONVD * 2;
constexpr size_t OFF_WOUT = OFF_WIN + (size_t)4 * NFF2 * D * 2;
constexpr size_t OFF_SSMIN = OFF_WOUT + (size_t)4 * D * DFF * 2;
constexpr size_t OFF_SSMOUT = OFF_SSMIN + (size_t)NINP * D * 2;
constexpr size_t OFF_QKVW = OFF_SSMOUT + (size_t)D * DIN * 2;
constexpr size_t OFF_OW = OFF_QKVW + (size_t)QKVD * D * 2;
constexpr size_t OFF_HIN = OFF_OW + (size_t)D * D * 2;
constexpr size_t OFF_R = OFF_HIN + (size_t)T * D * 2;
constexpr size_t R_BYTES = (size_t)T * 5120 * 2;
constexpr size_t WS_NEED = OFF_R + R_BYTES;
static_assert(WS_NEED <= 536870912ull, "workspace map must fit 512 MiB");
constexpr size_t OFF_ACT = OFF_R;
constexpr size_t OFF_F = OFF_R + (size_t)T * DFF * 2;
constexpr size_t OFF_Z = OFF_R;
constexpr size_t OFF_XBC = OFF_R + (size_t)T * DIN * 2;
constexpr size_t OFF_QKV = OFF_R;
constexpr size_t OFF_AO = OFF_R + (size_t)T * QKVD * 2;
constexpr size_t OFF_ADAT = OFF_R;
constexpr size_t OFF_PART = OFF_F + (size_t)T * D * 2;
static_assert(OFF_PART + (size_t)11 * TS * D * 4 <= OFF_R + R_BYTES, "partials overlay");
static_assert(OFF_AO + (size_t)T * D * 2 <= OFF_F, "swa overlay");
static_assert(OFF_F + (size_t)T * D * 2 <= OFF_R + R_BYTES, "F overlay");
static_assert(OFF_F >= OFF_Z + (size_t)T * DIN * 2, "F must not overlap yn");

constexpr size_t O_Y = 0;
constexpr size_t O_SSMP = (size_t)T * D;
constexpr size_t O_CONVP = O_SSMP + (size_t)8 * 32 * 64 * 128;
constexpr size_t O_KP = O_CONVP + (size_t)8 * 3 * CONVD;
constexpr size_t O_VP = O_KP + (size_t)8 * 128 * 256;
constexpr size_t O_SSMS = O_VP + (size_t)8 * 128 * 256;
constexpr size_t O_CONVS = O_SSMS + (size_t)128 * 32 * 64 * 128;
constexpr size_t O_KS = O_CONVS + (size_t)128 * 3 * CONVD;
constexpr size_t O_VS = O_KS + (size_t)128 * 128 * 256;

constexpr int LDS_BYTES = 147456;
constexpr int NWAVES = 8;

__device__ __forceinline__ unsigned f2bf(float f) { unsigned u = __builtin_bit_cast(unsigned, f); return (u + 0x7fffu + ((u >> 16) & 1u)) >> 16; }
__device__ __forceinline__ unsigned pk2(float lo, float hi) { return f2bf(lo) | (f2bf(hi) << 16); }
typedef __bf16 bf16x2_t __attribute__((ext_vector_type(2)));
__device__ __forceinline__ unsigned cvt_pk_bf16(float lo, float hi) { f32x2 v = {lo, hi}; bf16x2_t b = __builtin_convertvector(v, bf16x2_t); return __builtin_bit_cast(unsigned, b); }
__device__ __forceinline__ float bflo(unsigned w) { return __uint_as_float(w << 16); }
__device__ __forceinline__ float bfhi(unsigned w) { return __uint_as_float(w & 0xffff0000u); }
__device__ __forceinline__ float bf1(bf16_t b) { return __uint_as_float((unsigned)b << 16); }
__device__ __forceinline__ float silu_f(float g) { return g * __builtin_amdgcn_rcpf(1.0f + __expf(-g)); }
__device__ __forceinline__ float wave_sum(float v) {
#pragma unroll
    for (int o = 1; o < 64; o <<= 1) v += __shfl_xor(v, o);
    return v;
}
__device__ __forceinline__ int seq_of(int row) { return row < TP ? (row >> 12) : 8 + ((row - TP) >> 3); }

namespace pg8 {
#define PG8_LAS __attribute__((address_space(3)))
constexpr int BM = 256, BK = 64, HALF = 128, HTB = HALF * BK * 2, STAGE_BYTES = 8 * HTB, NXCD = 8, WGM = 8;
__host__ __device__ __forceinline__ int lds_byte(int r, int c) { const int st = (r >> 4) * 2 + (c >> 5), rr = r & 15, cc = c & 31, ob = rr * 64 + cc * 2; return st * 1024 + (ob ^ (((ob >> 9) & 1) << 5)); }
__host__ __device__ __forceinline__ void stage_rc(int b, int& R, int& C) { const int st = b / 1024, sb = b % 1024, swz = sb ^ (((sb >> 9) & 1) << 5); R = (st >> 1) * 16 + swz / 64; C = (st & 1) * 32 + (swz % 64) / 2; }
__host__ __device__ __forceinline__ int perm32(int rho) { const int n = rho >> 4, i = rho & 15; return 8 * (i >> 2) + 4 * n + (i & 3); }
struct Unit { int pm, pn; };
struct Gemm { const bf16_t* A; const bf16_t* Bt; int M, N, K; int Kloop; };
struct StaticOrder {
    int nM, nN, nwg, G, c, sl;
    __host__ __device__ void init(int M, int N, int G_, int c_) { nM = M / BM; nN = N / BM; nwg = nM * nN; G = G_; c = c_; sl = 0; }
    __host__ __device__ void init_slices(int S, int G_, int c_) { nM = 4; nN = 4; nwg = 16 * S; G = G_; c = c_; sl = 1; }
    __host__ __device__ bool next(int i, Unit& u) const {
        const long L = (long)i * G + c; if (L >= nwg) return false;
        if (sl) { if (i > 0) return false; u.pm = ((int)L & 15) >> 2; u.pn = (int)L & 3; return true; }
        int wgid = (int)L; { const int q = nwg / NXCD, r = nwg % NXCD, xcd = wgid % NXCD, off = wgid / NXCD; wgid = (xcd < r ? xcd * (q + 1) : r * (q + 1) + (xcd - r) * q) + off; }
        const int nig = WGM * nN, gid = wgid / nig, fm = gid * WGM, gsz = (nM - fm) < WGM ? (nM - fm) : WGM;
        u.pm = fm + ((wgid % nig) % gsz); u.pn = (wgid % nig) / gsz; return true;
    }
    __device__ __forceinline__ void a_ready(const Unit&) const {}
    __device__ __forceinline__ void done(const Unit&) const {}
};

template <class Epi, class Sched, bool ALIGN_EPI = false, bool SP2 = false>
__device__ __forceinline__ void gemm_phase(PG8_LAS unsigned char* lds, const Gemm g, const Sched& S, const Epi& E, const int tid) {
    const int wid = __builtin_amdgcn_readfirstlane(tid >> 6), lane = tid & 63, wr = wid >> 2, wc = wid & 3, fr = lane & 15, fq = lane >> 4;
    const int K = g.K, nt = (g.Kloop ? g.Kloop : g.K) / BK;
    unsigned voffA[2], voffB[2];
#pragma unroll
    for (int i = 0; i < 2; ++i) { int R, C; stage_rc(tid * 16 + i * 8192, R, C); const int Rb = Epi::PERM ? ((R & ~31) + perm32(R & 31)) : R;
        voffA[i] = (unsigned)(R * K + C) * 2u; voffB[i] = (unsigned)(Rb * K + C) * 2u; }
    const size_t kstep = (size_t)(BK * 2);
    const size_t hstep = (size_t)HALF * K * 2;
    const size_t tstep = 2 * hstep;
    const unsigned ldsw = (unsigned)wid * 1024u;
    const int aoff = lds_byte(wr * 64 + fr, fq * 8), boff = lds_byte(wc * 32 + fr, fq * 8);
#define PG8_SA(b, h) (((b) * 2 + (h)) * HTB)
#define PG8_SB(b, h) ((4 + (b) * 2 + (h)) * HTB)
#define PG8_STAGE(bufoff, gbase, voff) do { _Pragma("unroll") for (int _i = 0; _i < 2; ++_i) \
        __builtin_amdgcn_global_load_lds((const unsigned*)((const char*)(gbase) + (voff)[_i]), (PG8_LAS unsigned*)(lds + (bufoff) + ldsw + _i * 8192), 16, 0, 0); } while (0)
#define PG8_LDA(dst, b, h) do { _Pragma("unroll") for (int m = 0; m < 4; ++m) _Pragma("unroll") for (int k = 0; k < 2; ++k) dst[m][k] = *(const PG8_LAS bf16x8*)(lds + PG8_SA(b, h) + aoff + m * 2048 + k * 1024); } while (0)
#define PG8_LDB(dst, b, h) do { _Pragma("unroll") for (int n = 0; n < 2; ++n) _Pragma("unroll") for (int k = 0; k < 2; ++k) dst[n][k] = *(const PG8_LAS bf16x8*)(lds + PG8_SB(b, h) + boff + n * 2048 + k * 1024); } while (0)
#define PG8_MMA(ai, bj, At, Bt) do { __builtin_amdgcn_s_setprio(1); _Pragma("unroll") for (int m = 0; m < 4; ++m) _Pragma("unroll") for (int n = 0; n < 2; ++n) _Pragma("unroll") for (int k = 0; k < 2; ++k) \
        acc[ai][bj][m][n] = __builtin_amdgcn_mfma_f32_16x16x32_bf16(Bt[n][k], At[m][k], acc[ai][bj][m][n], 0, 0, 0); __builtin_amdgcn_s_setprio(0); } while (0)
#define PG8_WAIT_V(n) asm volatile("s_waitcnt vmcnt(" #n ")" ::: "memory")
#define PG8_WAIT_L(n) asm volatile("s_waitcnt lgkmcnt(" #n ")" ::: "memory")
#define PG8_BAR __builtin_amdgcn_s_barrier()
#define PG8_SCHED __builtin_amdgcn_sched_barrier(0)
    Unit cur, nxt; int ui = 0;
    if (!S.next(0, cur)) return;
    f32x4 acc[2][2][4][2];
#pragma unroll
    for (int a = 0; a < 2; ++a)
#pragma unroll
        for (int b = 0; b < 2; ++b)
#pragma unroll
            for (int m = 0; m < 4; ++m)
#pragma unroll
                for (int n = 0; n < 2; ++n) acc[a][b][m][n] = (f32x4){0.f, 0.f, 0.f, 0.f};
    bf16x8 At[4][2], B0[2][2], B1[2][2];
    const char* cA = (const char*)g.A + (size_t)cur.pm * tstep; const char* cB = (const char*)g.Bt + (size_t)cur.pn * tstep;
    S.a_ready(cur);
    if constexpr (SP2) {
        PG8_STAGE(PG8_SB(0, 0), cB, voffB); PG8_STAGE(PG8_SB(0, 1), cB + hstep, voffB); PG8_STAGE(PG8_SA(0, 0), cA, voffA); PG8_STAGE(PG8_SA(0, 1), cA + hstep, voffA);
        if (wr == 1) PG8_BAR;
        PG8_WAIT_V(2); PG8_BAR;
        PG8_STAGE(PG8_SB(1, 0), cB + kstep, voffB); PG8_STAGE(PG8_SA(1, 0), cA + kstep, voffA); PG8_STAGE(PG8_SB(1, 1), cB + hstep + kstep, voffB);
        PG8_WAIT_V(6); PG8_BAR;
    } else {
        PG8_STAGE(PG8_SB(0, 0), cB, voffB); PG8_STAGE(PG8_SA(0, 0), cA, voffA); PG8_STAGE(PG8_SB(0, 1), cB + hstep, voffB); PG8_STAGE(PG8_SA(0, 1), cA + hstep, voffA);
        if (wr == 1) PG8_BAR;
        PG8_WAIT_V(4); PG8_BAR;
        PG8_STAGE(PG8_SB(1, 0), cB + kstep, voffB); PG8_STAGE(PG8_SA(1, 0), cA + kstep, voffA); PG8_STAGE(PG8_SB(1, 1), cB + hstep + kstep, voffB);
        PG8_WAIT_V(6); PG8_BAR;
    }
    for (;;) {
        const bool has_next = S.next(ui + 1, nxt);
        const char* nA = has_next ? (const char*)g.A + (size_t)nxt.pm * tstep : cA; const char* nB = has_next ? (const char*)g.Bt + (size_t)nxt.pn * tstep : cB;
        for (int t = 0; t < nt; t += 2) {
            const bool last = (t == nt - 2);
            const char* a1 = cA + (size_t)(t + 1) * kstep;
            const char* a2 = last ? nA : cA + (size_t)(t + 2) * kstep; const char* b2 = last ? nB : cB + (size_t)(t + 2) * kstep;
            const char* a3 = a2 + kstep; const char* b3 = b2 + kstep;
            if (last && has_next) S.a_ready(nxt);
            if constexpr (SP2) {
            PG8_LDB(B0, 0, 0); PG8_LDB(B1, 0, 1); PG8_SCHED; PG8_LDA(At, 0, 0); PG8_STAGE(PG8_SA(1, 1), a1 + hstep, voffA);
            PG8_WAIT_V(8); PG8_WAIT_L(0); PG8_BAR; PG8_MMA(0, 0, At, B0); PG8_MMA(0, 1, At, B1); PG8_BAR; PG8_SCHED;
            PG8_LDA(At, 0, 1); PG8_STAGE(PG8_SB(0, 0), b2, voffB); PG8_STAGE(PG8_SB(0, 1), b2 + hstep, voffB); PG8_STAGE(PG8_SA(0, 0), a2, voffA);
            PG8_WAIT_V(8); PG8_WAIT_L(0); PG8_BAR; PG8_MMA(1, 0, At, B0); PG8_MMA(1, 1, At, B1); PG8_BAR; PG8_SCHED;
            PG8_LDB(B0, 1, 0); PG8_LDB(B1, 1, 1); PG8_SCHED; PG8_LDA(At, 1, 0); PG8_STAGE(PG8_SA(0, 1), a2 + hstep, voffA);
            PG8_WAIT_V(8); PG8_WAIT_L(0); PG8_BAR; PG8_MMA(0, 0, At, B0); PG8_MMA(0, 1, At, B1); PG8_BAR; PG8_SCHED;
            PG8_LDA(At, 1, 1); PG8_STAGE(PG8_SB(1, 0), b3, voffB); PG8_STAGE(PG8_SB(1, 1), b3 + hstep, voffB); PG8_STAGE(PG8_SA(1, 0), a3, voffA);
            PG8_WAIT_V(8); PG8_WAIT_L(0); PG8_BAR; PG8_MMA(1, 0, At, B0); PG8_MMA(1, 1, At, B1); PG8_BAR; PG8_SCHED;
            } else {
            PG8_LDB(B0, 0, 0); PG8_SCHED; PG8_LDA(At, 0, 0); PG8_STAGE(PG8_SA(1, 1), a1 + hstep, voffA);
            PG8_WAIT_L(8); PG8_BAR; PG8_WAIT_L(0); PG8_MMA(0, 0, At, B0); PG8_BAR; PG8_SCHED;
            PG8_LDB(B1, 0, 1); PG8_STAGE(PG8_SB(0, 0), b2, voffB);
            PG8_BAR; PG8_WAIT_L(0); PG8_MMA(0, 1, At, B1); PG8_BAR;
            PG8_LDA(At, 0, 1); PG8_STAGE(PG8_SA(0, 0), a2, voffA);
            PG8_BAR; PG8_WAIT_L(0); PG8_MMA(1, 0, At, B0); PG8_BAR; PG8_SCHED;
            PG8_STAGE(PG8_SB(0, 1), b2 + hstep, voffB);
            PG8_WAIT_V(6); PG8_BAR; PG8_MMA(1, 1, At, B1); PG8_BAR;
            PG8_LDB(B0, 1, 0); PG8_SCHED; PG8_LDA(At, 1, 0); PG8_STAGE(PG8_SA(0, 1), a2 + hstep, voffA);
            PG8_WAIT_L(8); PG8_BAR; PG8_WAIT_L(0); PG8_MMA(0, 0, At, B0); PG8_BAR; PG8_SCHED;
            PG8_LDB(B1, 1, 1); PG8_STAGE(PG8_SB(1, 0), b3, voffB);
            PG8_BAR; PG8_WAIT_L(0); PG8_MMA(0, 1, At, B1); PG8_BAR;
            PG8_LDA(At, 1, 1); PG8_STAGE(PG8_SA(1, 0), a3, voffA);
            PG8_BAR; PG8_WAIT_L(0); PG8_MMA(1, 0, At, B0); PG8_BAR; PG8_SCHED;
            PG8_STAGE(PG8_SB(1, 1), b3 + hstep, voffB);
            PG8_WAIT_V(6); PG8_BAR; PG8_MMA(1, 1, At, B1); PG8_BAR;
            }
        }
        if constexpr (ALIGN_EPI) { if (wr == 0) PG8_BAR; }
        E(acc, cur, wr, wc, fr, fq);
        if (!has_next) break;
#pragma unroll
        for (int a = 0; a < 2; ++a)
#pragma unroll
            for (int b = 0; b < 2; ++b)
#pragma unroll
                for (int m = 0; m < 4; ++m)
#pragma unroll
                    for (int n = 0; n < 2; ++n) acc[a][b][m][n] = (f32x4){0.f, 0.f, 0.f, 0.f};
        cur = nxt; cA = nA; cB = nB; ++ui;
        if constexpr (ALIGN_EPI) { if (wr == 1) PG8_BAR; }
    }
    PG8_WAIT_V(0);
    if constexpr (!ALIGN_EPI) { if (wr == 0) PG8_BAR; }
    PG8_BAR;
#undef PG8_SA
#undef PG8_SB
#undef PG8_STAGE
#undef PG8_LDA
#undef PG8_LDB
#undef PG8_MMA
#undef PG8_WAIT_V
#undef PG8_WAIT_L
#undef PG8_BAR
#undef PG8_SCHED
}
}

typedef f32x4 AccT[2][2][4][2];

struct EpiSwiglu {
    static constexpr bool PERM = true;
    bf16_t* O;
    __device__ __forceinline__ void operator()(const AccT& acc, const pg8::Unit& u, int wr, int wc, int fr, int fq) const {
        const int row0 = u.pm * 256 + wr * 64 + fr, col0 = u.pn * 128 + wc * 32 + 8 * fq;
#pragma unroll
        for (int ai = 0; ai < 2; ++ai)
#pragma unroll
            for (int m = 0; m < 4; ++m) {
                bf16_t* p = O + (size_t)(row0 + ai * 128 + m * 16) * DFF + col0;
                const f32x4 g0 = acc[ai][0][m][0], g1 = acc[ai][0][m][1], u0 = acc[ai][1][m][0], u1 = acc[ai][1][m][1];
                u32x4 w;
                w.x = cvt_pk_bf16(silu_f(g0[0]) * u0[0], silu_f(g0[1]) * u0[1]); w.y = cvt_pk_bf16(silu_f(g0[2]) * u0[2], silu_f(g0[3]) * u0[3]);
                w.z = cvt_pk_bf16(silu_f(g1[0]) * u1[0], silu_f(g1[1]) * u1[1]); w.w = cvt_pk_bf16(silu_f(g1[2]) * u1[2], silu_f(g1[3]) * u1[3]);
                *(u32x4*)p = w;
            }
    }
};
struct EpiRows {
    static constexpr bool PERM = true;
    bf16_t* O; const float* bias; float* pss; float* part;
    __device__ __forceinline__ void operator()(const AccT& acc, const pg8::Unit& u, int wr, int wc, int fr, int fq) const {
        const int row0 = u.pm * 256 + wr * 64 + fr, col0 = u.pn * 256 + wc * 32 + 8 * fq;
        if (part) {
            float* rp = part + (size_t)row0 * D + col0;
#pragma unroll
            for (int ai = 0; ai < 2; ++ai) {
#pragma unroll
                for (int m = 0; m < 4; ++m) {
#pragma unroll
                    for (int bj = 0; bj < 2; ++bj) { *(f32x4*)(rp + bj * 128) = acc[ai][bj][m][0]; *(f32x4*)(rp + bj * 128 + 4) = acc[ai][bj][m][1]; }
                    rp += 16 * D;
                }
                rp += 64 * D;
            }
            return;
        }
        f32x4 bv[2][2];
#pragma unroll
        for (int bj = 0; bj < 2; ++bj)
#pragma unroll
            for (int n = 0; n < 2; ++n) bv[bj][n] = bias ? *(const f32x4*)(bias + col0 + bj * 128 + 4 * n) : (f32x4){0.f, 0.f, 0.f, 0.f};
#pragma unroll
        for (int ai = 0; ai < 2; ++ai)
#pragma unroll
            for (int m = 0; m < 4; ++m) {
                const int row = row0 + ai * 128 + m * 16;
                float ss = 0.f;
#pragma unroll
                for (int bj = 0; bj < 2; ++bj) {
                    const f32x4 v0 = acc[ai][bj][m][0] + bv[bj][0], v1 = acc[ai][bj][m][1] + bv[bj][1];
                    ss += (v0[0] * v0[0] + v0[1] * v0[1]) + (v0[2] * v0[2] + v0[3] * v0[3]) + (v1[0] * v1[0] + v1[1] * v1[1]) + (v1[2] * v1[2] + v1[3] * v1[3]);
                    u32x4 w; w.x = cvt_pk_bf16(v0[0], v0[1]); w.y = cvt_pk_bf16(v0[2], v0[3]); w.z = cvt_pk_bf16(v1[0], v1[1]); w.w = cvt_pk_bf16(v1[2], v1[3]);
                    *(u32x4*)(O + (size_t)row * D + col0 + bj * 128) = w;
                }
                ss += __shfl_xor(ss, 16); ss += __shfl_xor(ss, 32);
                if (fq == 0) pss[(size_t)row * 16 + u.pn * 4 + wc] = ss;
            }
    }
};
struct EpiMod {
    static constexpr bool PERM = true;
    float* O; const float* bias;
    __device__ __forceinline__ void operator()(const AccT& acc, const pg8::Unit& u, int wr, int wc, int fr, int fq) const {
        const int row0 = u.pm * 256 + wr * 64 + fr, col0 = u.pn * 256 + wc * 32 + 8 * fq;
#pragma unroll
        for (int ai = 0; ai < 2; ++ai)
#pragma unroll
            for (int m = 0; m < 4; ++m) {
                const int row = row0 + ai * 128 + m * 16;
                if (row < NSEQ) {
#pragma unroll
                    for (int bj = 0; bj < 2; ++bj) {
                        const int c = col0 + bj * 128; const int l = c / 9216, cc = c - l * 9216;
                        float* p = O + ((size_t)l * NSEQ + row) * 9216 + cc;
                        *(f32x4*)p = acc[ai][bj][m][0] + *(const f32x4*)(bias + c);
                        *(f32x4*)(p + 4) = acc[ai][bj][m][1] + *(const f32x4*)(bias + c + 4);
                    }
                }
            }
    }
};
struct EpiInproj {
    static constexpr bool PERM = true;
    bf16_t* Z; bf16_t* XBC; bf16_t* HALO; float* DTS; const float* dt_bias;
    __device__ __forceinline__ void operator()(const AccT& acc, const pg8::Unit& u, int wr, int wc, int fr, int fq) const {
        const int row0 = u.pm * 256 + wr * 64 + fr, col0 = u.pn * 256 + wc * 32 + 8 * fq;
        if (u.pn == 20) {
            if (wc == 0) {
                const f32x4 b0 = *(const f32x4*)(dt_bias + 8 * fq), b1 = *(const f32x4*)(dt_bias + 8 * fq + 4);
#pragma unroll
                for (int ai = 0; ai < 2; ++ai)
#pragma unroll
                    for (int m = 0; m < 4; ++m) {
                        const int row = row0 + ai * 128 + m * 16;
                        f32x4 v0 = acc[ai][0][m][0] + b0, v1 = acc[ai][0][m][1] + b1;
#pragma unroll
                        for (int e = 0; e < 4; ++e) { v0[e] = v0[e] > 20.f ? v0[e] : log1pf(__expf(v0[e])); v1[e] = v1[e] > 20.f ? v1[e] : log1pf(__expf(v1[e])); }
                        *(f32x4*)(DTS + (size_t)row * 32 + 8 * fq) = v0; *(f32x4*)(DTS + (size_t)row * 32 + 8 * fq + 4) = v1;
                    }
            }
            return;
        }
        const bool isz = u.pn < 8;
        bf16_t* base = isz ? Z : XBC; const int ld = isz ? DIN : CONVD; const int cb = isz ? col0 : col0 - DIN;
#pragma unroll
        for (int ai = 0; ai < 2; ++ai)
#pragma unroll
            for (int m = 0; m < 4; ++m) {
                const int row = row0 + ai * 128 + m * 16;
#pragma unroll
                for (int bj = 0; bj < 2; ++bj) {
                    const f32x4 v0 = acc[ai][bj][m][0], v1 = acc[ai][bj][m][1];
                    u32x4 w; w.x = cvt_pk_bf16(v0[0], v0[1]); w.y = cvt_pk_bf16(v0[2], v0[3]); w.z = cvt_pk_bf16(v1[0], v1[1]); w.w = cvt_pk_bf16(v1[2], v1[3]);
                    *(u32x4*)(base + (size_t)row * ld + cb + bj * 128) = w;
                    if (!isz && (row & 127) >= 125) *(u32x4*)(HALO + ((size_t)(row >> 7) * 3 + ((row & 127) - 125)) * CONVD + cb + bj * 128) = w;
                }
            }
    }
};
struct EpiQkv {
    static constexpr bool PERM = true;
    bf16_t* O; const float* bias;
    __device__ __forceinline__ void operator()(const AccT& acc, const pg8::Unit& u, int wr, int wc, int fr, int fq) const {
        const int row0 = u.pm * 256 + wr * 64 + fr, col0 = u.pn * 256 + wc * 32 + 8 * fq;
        f32x4 bv[2][2];
#pragma unroll
        for (int bj = 0; bj < 2; ++bj)
#pragma unroll
            for (int n = 0; n < 2; ++n) bv[bj][n] = *(const f32x4*)(bias + col0 + bj * 128 + 4 * n);
#pragma unroll
        for (int ai = 0; ai < 2; ++ai)
#pragma unroll
            for (int m = 0; m < 4; ++m) {
                const int row = row0 + ai * 128 + m * 16;
#pragma unroll
                for (int bj = 0; bj < 2; ++bj) {
                    const f32x4 v0 = acc[ai][bj][m][0] + bv[bj][0], v1 = acc[ai][bj][m][1] + bv[bj][1];
                    u32x4 w; w.x = cvt_pk_bf16(v0[0], v0[1]); w.y = cvt_pk_bf16(v0[2], v0[3]); w.z = cvt_pk_bf16(v1[0], v1[1]); w.w = cvt_pk_bf16(v1[2], v1[3]);
                    *(u32x4*)(O + (size_t)row * QKVD + col0 + bj * 128) = w;
                }
            }
    }
};

struct Args { const float* in[28]; float* out; unsigned char* ws; };

struct Ctx {
    LAS unsigned char* lds;
    int tid, lane, wave, gw, ngw, G, bid;
    const float* const* in;
    float* out; unsigned char* ws; bool dry;
    float* out2; unsigned char* ws2;
};

__device__ __forceinline__ void p0_item(const float* W, int N, int K, bf16_t* WT, int dest_row0, int src_col0, int k0, LAS float* scr, int lane) {
    if (src_col0 >= 0) {
        float wv[32];
#pragma unroll
        for (int i = 0; i < 32; ++i) wv[i] = W[(size_t)(k0 + 2 * i + (lane >> 5)) * N + src_col0 + (lane & 31)];
#pragma unroll
        for (int i = 0; i < 32; ++i) scr[(2 * i + (lane >> 5)) * 33 + (lane & 31)] = wv[i];
    } else {
#pragma unroll 8
        for (int i = 0; i < 32; ++i) { const int kk = 2 * i + (lane >> 5); scr[kk * 33 + (lane & 31)] = 0.f; }
    }
    asm volatile("s_waitcnt lgkmcnt(0)" ::: "memory");
    const int c = lane & 7;
#pragma unroll
    for (int j = 0; j < 4; ++j) { const int n = (lane >> 3) + 8 * j; const LAS float* s = scr + (8 * c) * 33 + n;
        u32x4 o; o.x = cvt_pk_bf16(s[0 * 33], s[1 * 33]); o.y = cvt_pk_bf16(s[2 * 33], s[3 * 33]); o.z = cvt_pk_bf16(s[4 * 33], s[5 * 33]); o.w = cvt_pk_bf16(s[6 * 33], s[7 * 33]);
        *(u32x4*)(WT + (size_t)(dest_row0 + n) * K + k0 + 8 * c) = o; }
    asm volatile("s_waitcnt lgkmcnt(0)" ::: "memory");
}
__device__ __forceinline__ void p0_run(const Ctx& c, int lo1, int n1, int lo2, int n2, int lo3, int n3, int vw, int nvw) {
    LAS float* scr = (LAS float*)(c.lds + c.wave * 16384);
    constexpr int I_ADA = 2 * 16 * 288, I_WIN = 4 * 16 * 176, I_WOUT = 4 * 44 * 32, I_SIN = 16 * 168, I_SOUT = 32 * 32, I_QKV = 16 * 48, I_O = 16 * 32;
    for (int v = vw; v < n1 + n2 + n3; v += nvw) {
        int r = v < n1 ? lo1 + v : (v < n1 + n2 ? lo2 + (v - n1) : lo3 + (v - n1 - n2));
        if (r < I_ADA) { const int l = r / 4608, rr = r % 4608, kb = rr / 288, nb = rr % 288;
            p0_item(GIN(c, 8) + (size_t)l * 1024 * 9216, 9216, 1024, (bf16_t*)(c.ws + OFF_ADAT), l * 9216 + nb * 32, nb * 32, kb * 64, scr, c.lane); continue; } r -= I_ADA;
        if (r < I_WIN) { const int f = r / 2816, rr = r % 2816, kb = rr / 176, nb = rr % 176; const int d0 = nb * 32, pn = d0 >> 8, bj = (d0 >> 7) & 1, cc = d0 & 127;
            p0_item(GIN(c, 12) + (size_t)f * 1024 * NFF2, NFF2, 1024, (bf16_t*)(c.ws + OFF_WIN) + (size_t)f * NFF2 * 1024, d0, bj * DFF + pn * 128 + cc, kb * 64, scr, c.lane); continue; } r -= I_WIN;
        if (r < I_WOUT) { const int f = r / 1408, rr = r % 1408, kb = rr / 32, nb = rr % 32;
            p0_item(GIN(c, 13) + (size_t)f * DFF * 1024, 1024, DFF, (bf16_t*)(c.ws + OFF_WOUT) + (size_t)f * 1024 * DFF, nb * 32, nb * 32, kb * 64, scr, c.lane); continue; } r -= I_WOUT;
        if (r < I_SIN) { const int kb = r / 168, nb = r % 168;
            p0_item(GIN(c, 14), NIN_REAL, 1024, (bf16_t*)(c.ws + OFF_SSMIN), nb * 32, nb < 161 ? nb * 32 : -1, kb * 64, scr, c.lane); continue; } r -= I_SIN;
        if (r < I_SOUT) { const int kb = r / 32, nb = r % 32;
            p0_item(GIN(c, 21), 1024, DIN, (bf16_t*)(c.ws + OFF_SSMOUT), nb * 32, nb * 32, kb * 64, scr, c.lane); continue; } r -= I_SOUT;
        if (r < I_QKV) { const int kb = r / 48, nb = r % 48;
            p0_item(GIN(c, 22), QKVD, 1024, (bf16_t*)(c.ws + OFF_QKVW), nb * 32, nb * 32, kb * 64, scr, c.lane); continue; } r -= I_QKV;
        { const int kb = r / 32, nb = r % 32;
            p0_item(GIN(c, 25), 1024, 1024, (bf16_t*)(c.ws + OFF_OW), nb * 32, nb * 32, kb * 64, scr, c.lane); }
    }
}
__device__ __forceinline__ void p0_phase(const Ctx& c) {
    p0_run(c, 0, 12032, 0, 0, 0, 0, c.gw, c.ngw);
    bf16_t* CS = (bf16_t*)(c.ws + OFF_CS);
    for (int row = c.gw; row < 256; row += c.ngw) {
        const float* src = row < 8 ? GIN(c, 6) + (size_t)row * D : (row < NSEQ ? GIN(c, 7) + (size_t)(row - 8) * D : nullptr);
#pragma unroll
        for (int j = 0; j < 4; ++j) {
            f32x4 v = src ? *(const f32x4*)(src + 4 * (c.lane + 64 * j)) : (f32x4){0.f, 0.f, 0.f, 0.f};
            if (src) { v[0] = silu_f(v[0]); v[1] = silu_f(v[1]); v[2] = silu_f(v[2]); v[3] = silu_f(v[3]); }
            u32x2 w; w.x = pk2(v[0], v[1]); w.y = pk2(v[2], v[3]);
            *(u32x2*)(CS + (size_t)row * D + 4 * (c.lane + 64 * j)) = w;
        }
    }
}

struct NormRow { f32x4 v[4]; u32x2 xb[4]; u32x2 f[4]; float p; };
__device__ __forceinline__ void norm_load(NormRow& r, const float* xin, const bf16_t* F, const float* PSS, int row, int lane, bool has_upd, bool xf32) {
    if (xf32) {
#pragma unroll
        for (int j = 0; j < 4; ++j) r.v[j] = *(const f32x4*)(xin + 4 * (lane + 64 * j));
    } else {
#pragma unroll
        for (int j = 0; j < 4; ++j) r.xb[j] = *(const u32x2*)((const bf16_t*)xin + 4 * (lane + 64 * j));
    }
    if (has_upd) {
#pragma unroll
        for (int j = 0; j < 4; ++j) r.f[j] = *(const u32x2*)(F + (size_t)row * D + 4 * (lane + 64 * j));
        r.p = PSS[(size_t)row * 16 + (lane & 15)];
    }
}
__device__ __forceinline__ void norm_phase(const Ctx& c, int s) {
    const bool has_upd = s > 0, has_out = s < 6, xf32 = s <= 1;
    const int sp = s > 0 ? s - 1 : 0, lp = sp / 3, subp = sp % 3, l = has_out ? s / 3 : 0, sub = has_out ? s % 3 : 0;
    const float coef = (subp == 1) ? 1.0f : 0.5f;
    const float* MOD = (const float*)(c.ws + OFF_MOD);
    const float* PSS = (const float*)(c.ws + OFF_PSS);
    const bf16_t* F = (const bf16_t*)(c.ws + OFF_F);
    bf16_t* HIN = (bf16_t*)(c.ws + OFF_HIN);
    const float* post = GIN(c, 11) + (size_t)(lp * 3 + subp) * D;
    const float* pre = GIN(c, 10) + (size_t)(l * 3 + sub) * D;
    float* xo = c.dry ? (float*)(c.ws + OFF_XBC) : c.out;
    const int lane = c.lane;
    f32x4 gp[4], am[4], sh[4];
    int cur_seq = -1;
#define NORM_PARAMS(seq_) do { if ((seq_) != cur_seq) { cur_seq = (seq_); \
        const float* gate_ = MOD + ((size_t)lp * NSEQ + (seq_)) * 9216 + subp * 3072 + 2048; \
        const float* shift_ = MOD + ((size_t)l * NSEQ + (seq_)) * 9216 + sub * 3072; \
        _Pragma("unroll") for (int j = 0; j < 4; ++j) { const int col = 4 * (lane + 64 * j); \
            if (has_upd) gp[j] = *(const f32x4*)(gate_ + col) * *(const f32x4*)(post + col) * coef; \
            if (has_out) { sh[j] = *(const f32x4*)(shift_ + col); am[j] = *(const f32x4*)(pre + col) * (*(const f32x4*)(shift_ + 1024 + col) + 1.0f); } } } } while (0)
#define NORM_BODY(row_, v, fv, rf) do { \
        if (has_upd) { _Pragma("unroll") for (int j = 0; j < 4; ++j) { v[j] = v[j] + gp[j] * fv[j] * (rf); \
                if (has_out) { u32x2 w_; w_.x = cvt_pk_bf16(v[j][0], v[j][1]); w_.y = cvt_pk_bf16(v[j][2], v[j][3]); *(u32x2*)((bf16_t*)(xo + (size_t)(row_) * D) + 4 * (lane + 64 * j)) = w_; } \
                else *(f32x4*)(xo + (size_t)(row_) * D + 4 * (lane + 64 * j)) = v[j]; } } \
        if (has_out) { float ss_ = 0.f; \
            _Pragma("unroll") for (int j = 0; j < 4; ++j) ss_ += (v[j][0] * v[j][0] + v[j][1] * v[j][1]) + (v[j][2] * v[j][2] + v[j][3] * v[j][3]); \
            const float rs_ = rsqrtf(wave_sum(ss_) * (1.0f / D) + EPS); \
            _Pragma("unroll") for (int j = 0; j < 4; ++j) { const f32x4 o_ = v[j] * am[j] * rs_ + sh[j]; \
                u32x2 w_; w_.x = cvt_pk_bf16(o_[0], o_[1]); w_.y = cvt_pk_bf16(o_[2], o_[3]); *(u32x2*)(HIN + (size_t)(row_) * D + 4 * (lane + 64 * j)) = w_; } } } while (0)
    const int rb = (int)((long)c.gw * TP / c.ngw), re = (int)((long)(c.gw + 1) * TP / c.ngw);
    if (rb < re) {
        NormRow nx[2];
#pragma unroll
        for (int k = 0; k < 2; ++k) { nx[k].p = 0.f;
#pragma unroll
            for (int j = 0; j < 4; ++j) { nx[k].f[j].x = 0u; nx[k].f[j].y = 0u; nx[k].xb[j].x = 0u; nx[k].xb[j].y = 0u; nx[k].v[j] = (f32x4){0.f, 0.f, 0.f, 0.f}; } }
#define NORM_XIN(r_) (xf32 ? GIN(c, 0) + (size_t)(r_) * D : c.out + (size_t)(r_) * D)
        norm_load(nx[0], NORM_XIN(rb), F, PSS, rb, lane, has_upd, xf32);
        if (rb + 1 < re) norm_load(nx[1], NORM_XIN(rb + 1), F, PSS, rb + 1, lane, has_upd, xf32);
        for (int row0 = rb; row0 < re; row0 += 2) {
            NormRow cu[2];
            cu[0] = nx[0]; cu[1] = nx[1];
            if (row0 + 2 < re) norm_load(nx[0], NORM_XIN(row0 + 2), F, PSS, row0 + 2, lane, has_upd, xf32);
            if (row0 + 3 < re) norm_load(nx[1], NORM_XIN(row0 + 3), F, PSS, row0 + 3, lane, has_upd, xf32);
#pragma unroll
            for (int k = 0; k < 2; ++k) {
                const int row = row0 + k;
                if (row < re) {
                    NORM_PARAMS(row >> 12);
                    f32x4 v[4], fv[4]; float rf = 0.f;
#pragma unroll
                    for (int j = 0; j < 4; ++j) { v[j] = xf32 ? cu[k].v[j] : (f32x4){bflo(cu[k].xb[j].x), bfhi(cu[k].xb[j].x), bflo(cu[k].xb[j].y), bfhi(cu[k].xb[j].y)};
                        fv[j] = (f32x4){bflo(cu[k].f[j].x), bfhi(cu[k].f[j].x), bflo(cu[k].f[j].y), bfhi(cu[k].f[j].y)}; }
                    if (has_upd) { float p = cu[k].p; p += __shfl_xor(p, 1); p += __shfl_xor(p, 2); p += __shfl_xor(p, 4); p += __shfl_xor(p, 8); rf = rsqrtf(p * (1.0f / D) + EPS); }
                    NORM_BODY(row, v, fv, rf);
                }
            }
        }
#undef NORM_XIN
    }
    {
        const int nsl = (subp != 1) ? DFF / 256 : (lp == 0 ? DIN / 256 : D / 256);
        const float* obias = (subp == 1 && lp == 1) ? GIN(c, 26) : nullptr;
        const float* PART = (const float*)(c.ws + OFF_PART);
        for (int rs = c.gw; rs < TS; rs += c.ngw) {
            const int row = TP + rs;
            f32x4 v[4], fv[4]; float rf = 0.f;
            if (xf32) {
#pragma unroll
                for (int j = 0; j < 4; ++j) v[j] = *(const f32x4*)(GIN(c, 1) + (size_t)rs * D + 4 * (lane + 64 * j));
            } else {
#pragma unroll
                for (int j = 0; j < 4; ++j) { const u32x2 xb = *(const u32x2*)((const bf16_t*)(c.out + (size_t)row * D) + 4 * (lane + 64 * j)); v[j] = (f32x4){bflo(xb.x), bfhi(xb.x), bflo(xb.y), bfhi(xb.y)}; }
            }
#pragma unroll
            for (int j = 0; j < 4; ++j) fv[j] = (f32x4){0.f, 0.f, 0.f, 0.f};
            if (has_upd) {
#pragma unroll
                for (int j = 0; j < 4; ++j) if (obias) fv[j] = *(const f32x4*)(obias + 4 * (lane + 64 * j));
                for (int k0 = 0; k0 < nsl; k0 += 4) {
                    f32x4 t[4][4];
#pragma unroll
                    for (int kk = 0; kk < 4; ++kk)
#pragma unroll
                        for (int j = 0; j < 4; ++j) t[kk][j] = (k0 + kk < nsl) ? *(const f32x4*)(PART + ((size_t)(k0 + kk) * TS + rs) * D + 4 * (lane + 64 * j)) : (f32x4){0.f, 0.f, 0.f, 0.f};
#pragma unroll
                    for (int kk = 0; kk < 4; ++kk)
#pragma unroll
                        for (int j = 0; j < 4; ++j) fv[j] = fv[j] + t[kk][j];
                }
                float ss = 0.f;
#pragma unroll
                for (int j = 0; j < 4; ++j) ss += (fv[j][0] * fv[j][0] + fv[j][1] * fv[j][1]) + (fv[j][2] * fv[j][2] + fv[j][3] * fv[j][3]);
                rf = rsqrtf(wave_sum(ss) * (1.0f / D) + EPS);
            }
            NORM_PARAMS(8 + (rs >> 3));
            NORM_BODY(row, v, fv, rf);
        }
    }
#undef NORM_PARAMS
#undef NORM_BODY
}

__device__ __forceinline__ void conv_phase(const Ctx& c) {
    bf16_t* XBC = (bf16_t*)(c.ws + OFF_XBC);
    const bf16_t* HALO = (const bf16_t*)(c.ws + OFF_HALO);
    const float* cw = GIN(c, 15); const float* cbias = GIN(c, 16); const float* sconv = GIN(c, 3);
    constexpr int NCONV = NCHUNK * 12, NACS = NCHUNK / 2;
    float* cso = c.dry ? (float*)(c.ws + OFF_HIN) : c.out + O_CONVS; float* cpo = c.dry ? (float*)(c.ws + OFF_HIN) + 2097152 : c.out + O_CONVP;
    for (int it = c.gw; it < NCONV + NACS; it += c.ngw) {
        if (it < NCONV) {
            const int ck = it / 12, sl = it % 12, ch = sl * 256 + c.lane * 4;
            const f32x4 w0 = *(const f32x4*)(cw + ch), w1 = *(const f32x4*)(cw + CONVD + ch), w2 = *(const f32x4*)(cw + 2 * CONVD + ch), w3 = *(const f32x4*)(cw + 3 * CONVD + ch);
            const f32x4 bb = *(const f32x4*)(cbias + ch);
            const bool samp = ck >= 256;
            f32x4 h0 = (f32x4){0.f, 0.f, 0.f, 0.f}, h1 = h0, h2 = h0;
            if (!samp && (ck & 31) != 0) {
                const bf16_t* hp = HALO + (size_t)(ck - 1) * 3 * CONVD + ch;
                const u32x2 a = *(const u32x2*)hp, b = *(const u32x2*)(hp + CONVD), d = *(const u32x2*)(hp + 2 * CONVD);
                h0 = (f32x4){bflo(a.x), bfhi(a.x), bflo(a.y), bfhi(a.y)}; h1 = (f32x4){bflo(b.x), bfhi(b.x), bflo(b.y), bfhi(b.y)}; h2 = (f32x4){bflo(d.x), bfhi(d.x), bflo(d.y), bfhi(d.y)};
            }
            const bool lastp = !samp && (ck & 31) == 31;
            for (int t0 = 0; t0 < 128; t0 += 16) {
                const size_t rbase = (size_t)ck * 128 + t0;
                u32x2 raw[16];
#pragma unroll
                for (int i = 0; i < 16; ++i) raw[i] = *(const u32x2*)(XBC + (rbase + i) * CONVD + ch);
                f32x4 sh[2][3];
                int sq = 0;
                if (samp) {
                    sq = (ck - 256) * 16 + (t0 >> 3);
#pragma unroll
                    for (int hf = 0; hf < 2; ++hf) { const float* sp = sconv + (size_t)(sq + hf) * 3 * CONVD + ch;
                        sh[hf][0] = *(const f32x4*)sp; sh[hf][1] = *(const f32x4*)(sp + CONVD); sh[hf][2] = *(const f32x4*)(sp + 2 * CONVD); }
                }
#pragma unroll
                for (int i = 0; i < 16; ++i) {
                    if (samp && (i & 7) == 0) { h0 = sh[i >> 3][0]; h1 = sh[i >> 3][1]; h2 = sh[i >> 3][2]; }
                    const f32x4 x = (f32x4){bflo(raw[i].x), bfhi(raw[i].x), bflo(raw[i].y), bfhi(raw[i].y)};
                    f32x4 o = w0 * h0 + w1 * h1 + w2 * h2 + w3 * x + bb;
                    o[0] = silu_f(o[0]); o[1] = silu_f(o[1]); o[2] = silu_f(o[2]); o[3] = silu_f(o[3]);
                    u32x2 w; w.x = cvt_pk_bf16(o[0], o[1]); w.y = cvt_pk_bf16(o[2], o[3]);
                    *(u32x2*)(XBC + (rbase + i) * CONVD + ch) = w;
                    if (samp) { if ((i & 7) >= 5) *(f32x4*)(cso + ((size_t)(sq + (i >> 3)) * 3 + ((i & 7) - 5)) * CONVD + ch) = x; }
                    else if (lastp && t0 == 112 && i >= 13) *(f32x4*)(cpo + ((size_t)(ck >> 5) * 3 + (i - 13)) * CONVD + ch) = x;
                    h0 = h1; h1 = h2; h2 = x;
                }
            }
        } else {
            const int ck = (it - NCONV) * 2 + (c.lane >> 5), h = c.lane & 31;
            const float A = -__expf(GIN(c, 18)[h]);
            const float* DTS = (const float*)(c.ws + OFF_DTS); float* ACS = (float*)(c.ws + OFF_ACS);
            const bool samp = ck >= 256;
            float cum = 0.f;
            for (int t0 = 0; t0 < 128; t0 += 8) {
                float d[8];
#pragma unroll
                for (int i = 0; i < 8; ++i) d[i] = DTS[((size_t)ck * 128 + t0 + i) * 32 + h];
                if (samp) cum = 0.f;
#pragma unroll
                for (int i = 0; i < 8; ++i) { cum += d[i] * A; ACS[((size_t)ck * 128 + t0 + i) * 32 + h] = cum; }
            }
        }
    }
}

constexpr int SROW = 272, XROW = 144;
constexpr int SC_C = 0, SC_B = 34816, SC_BS = 69632, SC_X = 104448, SC_H = 122880, SC_F = 140288;
static_assert(SC_F + 1024 <= LDS_BYTES - 64, "scan LDS");
#define MFMA16(a, b, c) __builtin_amdgcn_mfma_f32_16x16x32_bf16((a), (b), (c), 0, 0, 0)
typedef short v4i16_t __attribute__((ext_vector_type(4)));
__device__ __forceinline__ u32x2 tr_read(LAS unsigned char* p) { return __builtin_bit_cast(u32x2, __builtin_amdgcn_ds_read_tr16_b64_v4i16((LAS v4i16_t*)p)); }
__device__ __forceinline__ bf16x8 tr_frag(LAS unsigned char* img, int rs, int kb, int nb, int lane) {
    const int g = lane >> 4, qq = (lane >> 2) & 3, pp = lane & 3;
    LAS unsigned char* a = img + (kb + 8 * g + qq) * rs + (nb + 4 * pp) * 2;
    const u32x2 lo = tr_read(a), hi = tr_read(a + 4 * rs);
    u32x4 v; v.x = lo.x; v.y = lo.y; v.z = hi.x; v.w = hi.y;
    return __builtin_bit_cast(bf16x8, v);
}

__device__ __forceinline__ void scan_prompt_unit(const Ctx& c, int b, int h) {
    LAS unsigned char* lds = c.lds;
    const int tid = c.tid, lane = c.lane, w = c.wave, q = lane >> 4, c16 = lane & 15, g = h >> 3;
    bf16_t* XBC = (bf16_t*)(c.ws + OFF_XBC);
    const float* DTS = (const float*)(c.ws + OFF_DTS); const float* ACS = (const float*)(c.ws + OFF_ACS);
    const float Dh = GIN(c, 19)[h];
    LAS float* acsL = (LAS float*)(lds + SC_F); LAS float* dtL = acsL + 128;
    f32x4 hacc[4];
#pragma unroll
    for (int pt = 0; pt < 4; ++pt) hacc[pt] = (f32x4){0.f, 0.f, 0.f, 0.f};
    for (int i = tid; i < 64 * SROW / 4; i += 512) ((LAS unsigned*)(lds + SC_H))[i] = 0u;
    u32x4 pc[4], pb[4], px[2]; float pdt[4], pac[4], pa_last, pa_mine = 0.f, pd_mine = 0.f;
    const int prow = tid >> 4, pcc = tid & 15, xrow = tid >> 3, xcc = tid & 7;
#define SCAN_LOAD(ck_) do { const size_t r0_ = (size_t)b * PSEQ + (size_t)(ck_) * 128; \
        _Pragma("unroll") for (int i = 0; i < 4; ++i) { const bf16_t* rp = XBC + (r0_ + prow + 32 * i) * CONVD + g * 128 + pcc * 8; pc[i] = *(const u32x4*)(rp + 2560); pb[i] = *(const u32x4*)(rp + 2048); \
            pdt[i] = DTS[(r0_ + prow + 32 * i) * 32 + h]; pac[i] = ACS[(r0_ + prow + 32 * i) * 32 + h]; } \
        _Pragma("unroll") for (int i = 0; i < 2; ++i) px[i] = *(const u32x4*)(XBC + (r0_ + xrow + 64 * i) * CONVD + h * 64 + xcc * 8); \
        pa_last = ACS[(r0_ + 127) * 32 + h]; \
        if (tid < 128) { pa_mine = ACS[(r0_ + tid) * 32 + h]; pd_mine = DTS[(r0_ + tid) * 32 + h]; } } while (0)
    SCAN_LOAD(0);
    __syncthreads();
    for (int ck = 0; ck < 32; ++ck) {
        const size_t r0 = (size_t)b * PSEQ + (size_t)ck * 128;
        asm volatile("s_waitcnt vmcnt(0)" : "+v"(pa_last), "+v"(pa_mine), "+v"(pd_mine), "+v"(pdt[0]), "+v"(pdt[1]), "+v"(pdt[2]), "+v"(pdt[3]), "+v"(pac[0]), "+v"(pac[1]), "+v"(pac[2]), "+v"(pac[3]) :: "memory");
        asm volatile("" : "+v"(pc[0]), "+v"(pc[1]), "+v"(pc[2]), "+v"(pc[3]), "+v"(pb[0]), "+v"(pb[1]), "+v"(pb[2]), "+v"(pb[3]), "+v"(px[0]), "+v"(px[1]));
        const float acs_last = pa_last;
        if (tid < 128) { acsL[tid] = pa_mine; dtL[tid] = pd_mine; }
#pragma unroll
        for (int i = 0; i < 4; ++i) {
            const int row = prow + 32 * i;
            *(LAS u32x4*)(lds + SC_C + row * SROW + pcc * 16) = pc[i];
            *(LAS u32x4*)(lds + SC_B + row * SROW + pcc * 16) = pb[i];
            const float cf = pdt[i] * __expf(acs_last - pac[i]);
            u32x4 sb; sb.x = cvt_pk_bf16(bflo(pb[i].x) * cf, bfhi(pb[i].x) * cf); sb.y = cvt_pk_bf16(bflo(pb[i].y) * cf, bfhi(pb[i].y) * cf);
            sb.z = cvt_pk_bf16(bflo(pb[i].z) * cf, bfhi(pb[i].z) * cf); sb.w = cvt_pk_bf16(bflo(pb[i].w) * cf, bfhi(pb[i].w) * cf);
            *(LAS u32x4*)(lds + SC_BS + row * SROW + pcc * 16) = sb;
        }
#pragma unroll
        for (int i = 0; i < 2; ++i) *(LAS u32x4*)(lds + SC_X + (xrow + 64 * i) * XROW + xcc * 16) = px[i];
        __syncthreads();
        if (ck + 1 < 32) SCAN_LOAD(ck + 1);
        bf16x8 cf[4];
#pragma unroll
        for (int k = 0; k < 4; ++k) cf[k] = *(const LAS bf16x8*)(lds + SC_C + (16 * w + c16) * SROW + (32 * k + 8 * q) * 2);
        f32x4 cb[8];
#pragma unroll
        for (int st = 0; st < 8; ++st) {
            cb[st] = (f32x4){0.f, 0.f, 0.f, 0.f};
            if (st <= w) {
#pragma unroll
                for (int k = 0; k < 4; ++k) { const bf16x8 bf = *(const LAS bf16x8*)(lds + SC_B + (16 * st + c16) * SROW + (32 * k + 8 * q) * 2); cb[st] = MFMA16(bf, cf[k], cb[st]); }
            }
        }
        f32x4 yo[4];
#pragma unroll
        for (int pt = 0; pt < 4; ++pt) {
            yo[pt] = (f32x4){0.f, 0.f, 0.f, 0.f};
#pragma unroll
            for (int k = 0; k < 4; ++k) { const bf16x8 hf = *(const LAS bf16x8*)(lds + SC_H + (16 * pt + c16) * SROW + (32 * k + 8 * q) * 2); yo[pt] = MFMA16(hf, cf[k], yo[pt]); }
        }
        bf16x8 xf[2][4];
        {
            const float cdec = __expf(acs_last);
#pragma unroll
            for (int pt = 0; pt < 4; ++pt) hacc[pt] = hacc[pt] * cdec;
#pragma unroll
            for (int kl = 0; kl < 4; ++kl) {
                const bf16x8 btf = tr_frag(lds + SC_BS, SROW, 32 * kl, 16 * w, lane);
#pragma unroll
                for (int pt = 0; pt < 4; ++pt) {
                    const bf16x8 x_ = tr_frag(lds + SC_X, XROW, 32 * kl, 16 * pt, lane);
                    if (kl < 2) xf[kl][pt] = x_;
                    hacc[pt] = MFMA16(btf, x_, hacc[pt]);
                }
            }
        }
        __syncthreads();
        {
            const int l = 16 * w + c16; const float acs_l = acsL[l];
#pragma unroll
            for (int st = 0; st < 8; ++st) {
                if (st <= (w | 1)) {
                    u32x2 pk; pk.x = 0u; pk.y = 0u;
                    if (st <= w) {
                        const f32x4 as = *(const LAS f32x4*)(acsL + 16 * st + 4 * q), ds = *(const LAS f32x4*)(dtL + 16 * st + 4 * q);
                        float v[4];
#pragma unroll
                        for (int r = 0; r < 4; ++r) { const int s_ = 16 * st + 4 * q + r; const float e = __expf(acs_l - as[r]) * ds[r] * cb[st][r]; v[r] = (s_ <= l) ? e : 0.f; }
                        pk.x = cvt_pk_bf16(v[0], v[1]); pk.y = cvt_pk_bf16(v[2], v[3]);
                    }
                    *(LAS u32x2*)(lds + SC_B + l * SROW + (16 * st + 4 * q) * 2) = pk;
                }
            }
        }
        f32x4 yd[4];
#pragma unroll
        for (int pt = 0; pt < 4; ++pt) yd[pt] = (f32x4){0.f, 0.f, 0.f, 0.f};
#pragma unroll
        for (int ks = 0; ks < 4; ++ks) {
            if (ks <= (w >> 1)) {
                const bf16x8 wf = *(const LAS bf16x8*)(lds + SC_B + (16 * w + c16) * SROW + (32 * ks + 8 * q) * 2);
#pragma unroll
                for (int pt = 0; pt < 4; ++pt) { const bf16x8 x_ = (ks < 2) ? xf[ks & 1][pt] : tr_frag(lds + SC_X, XROW, 32 * ks, 16 * pt, lane); yd[pt] = MFMA16(x_, wf, yd[pt]); }
            }
        }
        {
            const int l = 16 * w + c16;
            const float el = __expf(acsL[l]);
#pragma unroll
            for (int pt = 0; pt < 4; ++pt) {
                const u32x2 xr = *(const LAS u32x2*)(lds + SC_X + l * XROW + (16 * pt + 4 * q) * 2);
                const float y0 = yd[pt][0] + el * yo[pt][0] + Dh * bflo(xr.x), y1 = yd[pt][1] + el * yo[pt][1] + Dh * bfhi(xr.x);
                const float y2 = yd[pt][2] + el * yo[pt][2] + Dh * bflo(xr.y), y3 = yd[pt][3] + el * yo[pt][3] + Dh * bfhi(xr.y);
                u32x2 o; o.x = cvt_pk_bf16(y0, y1); o.y = cvt_pk_bf16(y2, y3);
                *(u32x2*)(XBC + (r0 + l) * CONVD + h * 64 + 16 * pt + 4 * q) = o;
            }
        }
#pragma unroll
        for (int pt = 0; pt < 4; ++pt) { u32x2 pk; pk.x = cvt_pk_bf16(hacc[pt][0], hacc[pt][1]); pk.y = cvt_pk_bf16(hacc[pt][2], hacc[pt][3]);
            *(LAS u32x2*)(lds + SC_H + (16 * pt + c16) * SROW + (16 * w + 4 * q) * 2) = pk; }
        __syncthreads();
    }
#undef SCAN_LOAD
    float* sp = (c.dry ? (float*)(c.ws + OFF_HIN) : c.out + O_SSMP) + (size_t)(b * 32 + h) * 64 * 128;
#pragma unroll
    for (int pt = 0; pt < 4; ++pt) *(f32x4*)(sp + (size_t)(16 * pt + c16) * 128 + 16 * w + 4 * q) = hacc[pt];
}

__device__ __forceinline__ bf16x8 tr_frag8(LAS unsigned char* img, int rs, int nb, int lane) {
    const int qq = (lane >> 2) & 3, pp = lane & 3;
    LAS unsigned char* a = img + qq * rs + (nb + 4 * pp) * 2;
    const u32x2 lo = tr_read(a), hi = tr_read(a + 4 * rs);
    u32x4 v; const bool z = lane >= 16;
    v.x = z ? 0u : lo.x; v.y = z ? 0u : lo.y; v.z = z ? 0u : hi.x; v.w = z ? 0u : hi.y;
    return __builtin_bit_cast(bf16x8, v);
}
__device__ __forceinline__ void scan_sample_wave(const Ctx& c, int bs, int h) {
    constexpr int W_C = 0, W_B = 4352, W_BS = 8704, W_X = 10880, W_F = 12032;
    LAS unsigned char* L = c.lds + c.wave * 16384;
    LAS float* acsL = (LAS float*)(L + W_F); LAS float* dtL = acsL + 8;
    const int lane = c.lane, q = lane >> 4, c16 = lane & 15, g = h >> 3, l8 = lane >> 3, ch = lane & 7;
    bf16_t* XBC = (bf16_t*)(c.ws + OFF_XBC);
    const float* DTS = (const float*)(c.ws + OFF_DTS); const float* ACS = (const float*)(c.ws + OFF_ACS);
    const size_t r0 = (size_t)TP + (size_t)bs * 8;
    const float Dh = GIN(c, 19)[h];
    {
        const bf16_t* rp = XBC + (r0 + l8) * CONVD;
        const u32x4 b0 = *(const u32x4*)(rp + 2048 + g * 128 + ch * 16), b1 = *(const u32x4*)(rp + 2048 + g * 128 + ch * 16 + 8);
        const u32x4 c0 = *(const u32x4*)(rp + 2560 + g * 128 + ch * 16), c1 = *(const u32x4*)(rp + 2560 + g * 128 + ch * 16 + 8);
        const u32x4 xv = *(const u32x4*)(rp + h * 64 + ch * 8);
        const float dtl = DTS[(r0 + l8) * 32 + h], acl = ACS[(r0 + l8) * 32 + h], a7 = ACS[(r0 + 7) * 32 + h];
        const float cf = dtl * __expf(a7 - acl);
        asm volatile("s_waitcnt lgkmcnt(0)" ::: "memory");
        *(LAS u32x4*)(L + W_C + l8 * SROW + ch * 32) = c0; *(LAS u32x4*)(L + W_C + l8 * SROW + ch * 32 + 16) = c1;
        *(LAS u32x4*)(L + W_B + l8 * SROW + ch * 32) = b0; *(LAS u32x4*)(L + W_B + l8 * SROW + ch * 32 + 16) = b1;
        u32x4 s0, s1;
        s0.x = cvt_pk_bf16(bflo(b0.x) * cf, bfhi(b0.x) * cf); s0.y = cvt_pk_bf16(bflo(b0.y) * cf, bfhi(b0.y) * cf); s0.z = cvt_pk_bf16(bflo(b0.z) * cf, bfhi(b0.z) * cf); s0.w = cvt_pk_bf16(bflo(b0.w) * cf, bfhi(b0.w) * cf);
        s1.x = cvt_pk_bf16(bflo(b1.x) * cf, bfhi(b1.x) * cf); s1.y = cvt_pk_bf16(bflo(b1.y) * cf, bfhi(b1.y) * cf); s1.z = cvt_pk_bf16(bflo(b1.z) * cf, bfhi(b1.z) * cf); s1.w = cvt_pk_bf16(bflo(b1.w) * cf, bfhi(b1.w) * cf);
        *(LAS u32x4*)(L + W_BS + l8 * SROW + ch * 32) = s0; *(LAS u32x4*)(L + W_BS + l8 * SROW + ch * 32 + 16) = s1;
        *(LAS u32x4*)(L + W_X + l8 * XROW + ch * 16) = xv;
        if (lane < 8) { acsL[lane] = ACS[(r0 + lane) * 32 + h]; dtL[lane] = DTS[(r0 + lane) * 32 + h]; }
        asm volatile("s_waitcnt lgkmcnt(0)" ::: "memory");
    }
    const float a7 = acsL[7], cdec = __expf(a7);
    bf16x8 wf;
    {
        f32x4 cbt = (f32x4){0.f, 0.f, 0.f, 0.f};
#pragma unroll
        for (int k = 0; k < 4; ++k) {
            const bf16x8 a = *(const LAS bf16x8*)(L + W_B + c16 * SROW + (32 * k + 8 * q) * 2), b = *(const LAS bf16x8*)(L + W_C + c16 * SROW + (32 * k + 8 * q) * 2);
            cbt = MFMA16(a, b, cbt);
        }
        const int l = c16 & 7; const float acs_l = acsL[l];
        float wv[4];
#pragma unroll
        for (int r = 0; r < 4; ++r) { const int s_ = (4 * q + r) & 7; const float e = __expf(acs_l - acsL[s_]) * dtL[s_] * cbt[r]; wv[r] = (q < 2 && c16 < 8 && s_ <= l) ? e : 0.f; }
        const unsigned w0 = cvt_pk_bf16(wv[0], wv[1]), w1 = cvt_pk_bf16(wv[2], wv[3]);
        const unsigned h0_ = __shfl_down(w0, 16), h1_ = __shfl_down(w1, 16);
        u32x4 v; const bool z = lane >= 16;
        v.x = z ? 0u : w0; v.y = z ? 0u : w1; v.z = z ? 0u : h0_; v.w = z ? 0u : h1_;
        wf = __builtin_bit_cast(bf16x8, v);
    }
    float el[4];
#pragma unroll
    for (int r = 0; r < 4; ++r) el[r] = __expf(acsL[(4 * q + r) & 7]);
    const float* h0base = GIN(c, 2) + (size_t)(bs * 32 + h) * 64 * 128;
    float* hobase = (c.dry ? (float*)(c.ws + OFF_Z) : c.out + O_SSMS) + (size_t)(bs * 32 + h) * 64 * 128;
#pragma unroll 1
    for (int pb = 0; pb < 4; ++pb) {
        const int p = 16 * pb + c16;
        f32x4 h0[8];
#pragma unroll
        for (int nt = 0; nt < 8; ++nt) h0[nt] = *(const f32x4*)(h0base + (size_t)p * 128 + 16 * nt + 4 * q);
        const bf16x8 xsf = tr_frag8(L + W_X, XROW, 16 * pb, lane);
        f32x4 yd = MFMA16(wf, xsf, ((f32x4){0.f, 0.f, 0.f, 0.f}));
        f32x4 yo = (f32x4){0.f, 0.f, 0.f, 0.f};
#pragma unroll
        for (int a = 0; a < 4; ++a) {
            const u32x2 clo = *(const LAS u32x2*)(L + W_C + c16 * SROW + (32 * a + 4 * q) * 2), chi = *(const LAS u32x2*)(L + W_C + c16 * SROW + (32 * a + 16 + 4 * q) * 2);
            u32x4 av; av.x = clo.x; av.y = clo.y; av.z = chi.x; av.w = chi.y;
            u32x4 bv; bv.x = cvt_pk_bf16(h0[2 * a][0], h0[2 * a][1]); bv.y = cvt_pk_bf16(h0[2 * a][2], h0[2 * a][3]); bv.z = cvt_pk_bf16(h0[2 * a + 1][0], h0[2 * a + 1][1]); bv.w = cvt_pk_bf16(h0[2 * a + 1][2], h0[2 * a + 1][3]);
            yo = MFMA16(__builtin_bit_cast(bf16x8, av), __builtin_bit_cast(bf16x8, bv), yo);
        }
        {
            const u32x2 xr = tr_read(L + W_X + (4 * (q & 1) + ((lane >> 2) & 3)) * XROW + (16 * pb + 4 * (lane & 3)) * 2);
            const float xs[4] = {bflo(xr.x), bfhi(xr.x), bflo(xr.y), bfhi(xr.y)};
            if (q < 2) {
#pragma unroll
                for (int r = 0; r < 4; ++r) { const float y = yd[r] + el[r] * yo[r] + Dh * xs[r]; XBC[(r0 + 4 * q + r) * CONVD + h * 64 + p] = (bf16_t)f2bf(y); }
            }
        }
#pragma unroll
        for (int nt = 0; nt < 8; ++nt) {
            const bf16x8 bsf = tr_frag8(L + W_BS, SROW, 16 * nt, lane);
            const f32x4 S = MFMA16(bsf, xsf, ((f32x4){0.f, 0.f, 0.f, 0.f}));
            *(f32x4*)(hobase + (size_t)p * 128 + 16 * nt + 4 * q) = h0[nt] * cdec + S;
        }
    }
}
__device__ __forceinline__ void scan_phase(const Ctx& c, int mode) {
    if (mode != 2) for (int u = c.bid; u < 256; u += c.G) scan_prompt_unit(c, u >> 5, u & 31);
    if (mode != 1) for (int u = c.gw; u < 4096; u += c.ngw) scan_sample_wave(c, u >> 5, u & 31);
}

__device__ __forceinline__ void gate_phase(const Ctx& c) {
    const bf16_t* XBC = (const bf16_t*)(c.ws + OFF_XBC); bf16_t* Z = (bf16_t*)(c.ws + OFF_Z);
    const float* nw = GIN(c, 20);
    constexpr int NIT = T * 4, U = 4;
    for (int it0 = c.gw; it0 < NIT; it0 += U * c.ngw) {
        u32x4 yv[U], zv[U];
#pragma unroll
        for (int u = 0; u < U; ++u) {
            const int it = it0 + u * c.ngw;
            if (it < NIT) { const int row = it >> 2, col = (it & 3) * 512 + c.lane * 8;
                yv[u] = *(const u32x4*)(XBC + (size_t)row * CONVD + col); zv[u] = *(const u32x4*)(Z + (size_t)row * DIN + col); }
            else { yv[u] = (u32x4){0u, 0u, 0u, 0u}; zv[u] = yv[u]; }
        }
#pragma unroll
        for (int u = 0; u < U; ++u) {
            const int it = it0 + u * c.ngw;
            if (it < NIT) {
                const int row = it >> 2, col = (it & 3) * 512 + c.lane * 8;
                float y[8] = {bflo(yv[u].x), bfhi(yv[u].x), bflo(yv[u].y), bfhi(yv[u].y), bflo(yv[u].z), bfhi(yv[u].z), bflo(yv[u].w), bfhi(yv[u].w)};
                const float z[8] = {bflo(zv[u].x), bfhi(zv[u].x), bflo(zv[u].y), bfhi(zv[u].y), bflo(zv[u].z), bfhi(zv[u].z), bflo(zv[u].w), bfhi(zv[u].w)};
                float ss = 0.f;
#pragma unroll
                for (int j = 0; j < 8; ++j) { y[j] *= silu_f(z[j]); ss += y[j] * y[j]; }
                const float rs = rsqrtf(wave_sum(ss) * (1.0f / 512.0f) + EPS);
                const f32x4 n0 = *(const f32x4*)(nw + col), n1 = *(const f32x4*)(nw + col + 4);
                u32x4 o; o.x = cvt_pk_bf16(y[0] * rs * n0[0], y[1] * rs * n0[1]); o.y = cvt_pk_bf16(y[2] * rs * n0[2], y[3] * rs * n0[3]);
                o.z = cvt_pk_bf16(y[4] * rs * n1[0], y[5] * rs * n1[1]); o.w = cvt_pk_bf16(y[6] * rs * n1[2], y[7] * rs * n1[3]);
                *(u32x4*)(Z + (size_t)row * DIN + col) = o;
            }
        }
    }
}

constexpr int AT_K = 0, AT_KROW = 144, AT_V = 36864, AT_VROW = 144, AT_BT = 73728;
__device__ __forceinline__ void attn_bias(float (&bm)[9][4], const LAS float* bt, int ci, int q) {
#pragma unroll
    for (int jt = 0; jt < 9; ++jt)
#pragma unroll
        for (int r = 0; r < 4; ++r) { const int dist = 128 + ci - 16 * jt - 4 * q - r; const int dd = dist < 0 ? 0 : (dist > 128 ? 128 : dist); const float v = bt[dd]; bm[jt][r] = (dist >= 0 && dist <= 128) ? v : -INFINITY; }
}
__device__ __forceinline__ void attn_tile(LAS unsigned char* lds, const bf16x8 (&qf)[2], const float (&bm)[9][4], int i0, bool first, float sinkv,
                                          bf16_t* obase  , int nrows, int lane) {
    const int q = lane >> 4, c16 = lane & 15, kt0 = i0 >> 4;
    f32x4 s[9];
#pragma unroll
    for (int jt = 0; jt < 9; ++jt) {
        s[jt] = (f32x4){0.f, 0.f, 0.f, 0.f};
#pragma unroll
        for (int k = 0; k < 2; ++k) { const bf16x8 kf = *(const LAS bf16x8*)(lds + AT_K + (16 * (kt0 + jt) + c16) * AT_KROW + (32 * k + 8 * q) * 2); s[jt] = MFMA16(kf, qf[k], s[jt]); }
    }
    float mx = -INFINITY;
#pragma unroll
    for (int jt = 0; jt < 9; ++jt)
#pragma unroll
        for (int r = 0; r < 4; ++r) {
            float x = s[jt][r] * 0.125f + bm[jt][r];
            if (first) { const int j = 16 * (kt0 + jt) + 4 * q + r; x = (j >= 128) ? x : -INFINITY; }
            s[jt][r] = x; mx = fmaxf(mx, x);
        }
    mx = fmaxf(mx, __shfl_xor(mx, 16)); mx = fmaxf(mx, __shfl_xor(mx, 32)); mx = fmaxf(mx, sinkv);
    float sum = 0.f;
#pragma unroll
    for (int jt = 0; jt < 9; ++jt)
#pragma unroll
        for (int r = 0; r < 4; ++r) { const float e = __expf(s[jt][r] - mx); s[jt][r] = e; sum += e; }
    sum += __shfl_xor(sum, 16); sum += __shfl_xor(sum, 32);
    sum += __expf(sinkv - mx);
    const float inv = 1.0f / sum;
    f32x4 o[4];
#pragma unroll
    for (int dt = 0; dt < 4; ++dt) o[dt] = (f32x4){0.f, 0.f, 0.f, 0.f};
#pragma unroll
    for (int a = 0; a < 5; ++a) {
        u32x4 pw; pw.x = cvt_pk_bf16(s[2 * a][0] * inv, s[2 * a][1] * inv); pw.y = cvt_pk_bf16(s[2 * a][2] * inv, s[2 * a][3] * inv);
        if (a < 4) { pw.z = cvt_pk_bf16(s[2 * a + 1][0] * inv, s[2 * a + 1][1] * inv); pw.w = cvt_pk_bf16(s[2 * a + 1][2] * inv, s[2 * a + 1][3] * inv); } else { pw.z = 0u; pw.w = 0u; }
        const bf16x8 pa = __builtin_bit_cast(bf16x8, pw);
#pragma unroll
        for (int dt = 0; dt < 4; ++dt) {
            LAS unsigned char* vb = lds + AT_V + (16 * (kt0 + 2 * a) + 4 * q + ((lane >> 2) & 3)) * AT_VROW + (16 * dt + 4 * (lane & 3)) * 2;
            const u32x2 lo = tr_read(vb);
            u32x2 hi; hi.x = 0u; hi.y = 0u;
            if (a < 4) hi = tr_read(vb + 16 * AT_VROW);
            u32x4 vw; vw.x = lo.x; vw.y = lo.y; vw.z = hi.x; vw.w = hi.y;
            o[dt] = MFMA16(__builtin_bit_cast(bf16x8, vw), pa, o[dt]);
        }
    }
    if (c16 < nrows) {
#pragma unroll
        for (int dt = 0; dt < 4; ++dt) { u32x2 w; w.x = cvt_pk_bf16(o[dt][0], o[dt][1]); w.y = cvt_pk_bf16(o[dt][2], o[dt][3]);
            *(u32x2*)(obase + (size_t)(i0 + c16) * D + 16 * dt + 4 * q) = w; }
    }
}

__device__ __forceinline__ void attn_phase(const Ctx& c, int mode) {
    LAS unsigned char* lds = c.lds;
    const int tid = c.tid, w = c.wave;
    const bf16_t* QKV = (const bf16_t*)(c.ws + OFF_QKV); bf16_t* AO = (bf16_t*)(c.ws + OFF_AO);
    const float* rel = GIN(c, 27); const float* sinks = GIN(c, 24);
    for (int idx = tid; idx < 16 * 129; idx += 512) {
        const int h = idx / 129, d = idx % 129;
        int bk = d;
        if (d >= 16) { int lg = 16 + (int)(logf((float)d / 16.0f) / 2.0794415416798357f * 16.0f); bk = lg < 31 ? lg : 31; }
        ((LAS float*)(lds + AT_BT))[h * 132 + d] = rel[bk * 16 + h];
    }
    __syncthreads();
    for (int u = c.bid; u < (mode == 2 ? 0 : 1024); u += c.G) {
        const int b = u >> 7, qb = (u >> 2) & 31, g = u & 3;
        const size_t krow0 = (size_t)b * PSEQ + (size_t)qb * 128 - 128;
#pragma unroll
        for (int i = 0; i < 4; ++i) {
            const int idx = tid + 512 * i, j = idx >> 3, cc = idx & 7;
            u32x4 kv = (u32x4){0u, 0u, 0u, 0u}, vv = kv;
            if (qb > 0 || j >= 128) { const bf16_t* rp = QKV + (krow0 + j) * QKVD + g * 64 + cc * 8; kv = *(const u32x4*)(rp + 1024); vv = *(const u32x4*)(rp + 1280); }
            *(LAS u32x4*)(lds + AT_K + j * AT_KROW + cc * 16) = kv;
            *(LAS u32x4*)(lds + AT_V + j * AT_VROW + cc * 16) = vv;
        }
        const int hh = 4 * g + (w >> 1);
        const float sinkv = sinks[hh];
        const size_t qrow0 = (size_t)b * PSEQ + (size_t)qb * 128;
        const int lq = c.lane >> 4, lc = c.lane & 15;
        const bf16_t* qp = QKV + (qrow0 + (w & 1) * 64 + lc) * QKVD + hh * 64 + 8 * lq;
        bf16x8 qn[2];
#pragma unroll
        for (int k = 0; k < 2; ++k) qn[k] = *(const bf16x8*)(qp + 32 * k);
        float bm[9][4];
        attn_bias(bm, (const LAS float*)(lds + AT_BT) + hh * 132, lc, lq);
        __syncthreads();
#pragma unroll 1
        for (int ti = 0; ti < (mode == 3 ? 0 : 4); ++ti) {
            bf16x8 qc[2]; qc[0] = qn[0]; qc[1] = qn[1];
            if (ti + 1 < 4) {
#pragma unroll
                for (int k = 0; k < 2; ++k) qn[k] = *(const bf16x8*)(qp + (size_t)(16 * (ti + 1)) * QKVD + 32 * k);
            }
            attn_tile(lds, qc, bm, (w & 1) * 64 + 16 * ti, qb == 0, sinkv, AO + qrow0 * D + hh * 64, 16, c.lane);
        }
        __syncthreads();
    }
    const float* ck = GIN(c, 4); const float* cv = GIN(c, 5);
    for (int u = c.bid; u < ((mode == 1 || mode == 3) ? 0 : 512); u += c.G) {
        const int bs = u >> 2, g = u & 3;
        for (int idx = tid; idx < 144 * 8; idx += 512) {
            const int j = idx >> 3, cc = idx & 7;
            u32x4 kv = (u32x4){0u, 0u, 0u, 0u}, vv = kv;
            if (j < 128) {
                const float* kp = ck + (((size_t)bs * 128 + j) * 4 + g) * 64 + cc * 8; const float* vp = cv + (((size_t)bs * 128 + j) * 4 + g) * 64 + cc * 8;
                const f32x4 k0 = *(const f32x4*)kp, k1 = *(const f32x4*)(kp + 4), v0 = *(const f32x4*)vp, v1 = *(const f32x4*)(vp + 4);
                kv.x = pk2(k0[0], k0[1]); kv.y = pk2(k0[2], k0[3]); kv.z = pk2(k1[0], k1[1]); kv.w = pk2(k1[2], k1[3]);
                vv.x = pk2(v0[0], v0[1]); vv.y = pk2(v0[2], v0[3]); vv.z = pk2(v1[0], v1[1]); vv.w = pk2(v1[2], v1[3]);
            } else if (j < 136) {
                const bf16_t* rp = QKV + ((size_t)TP + (size_t)bs * 8 + (j - 128)) * QKVD + g * 64 + cc * 8; kv = *(const u32x4*)(rp + 1024); vv = *(const u32x4*)(rp + 1280);
            }
            *(LAS u32x4*)(lds + AT_K + j * AT_KROW + cc * 16) = kv;
            *(LAS u32x4*)(lds + AT_V + j * AT_VROW + cc * 16) = vv;
        }
        __syncthreads();
        if (w < 4) {
            const int hh = 4 * g + w;
            const size_t qrow0 = (size_t)TP + (size_t)bs * 8;
            const int lq = c.lane >> 4, lc = c.lane & 7;
            bf16x8 qf[2];
#pragma unroll
            for (int k = 0; k < 2; ++k) qf[k] = *(const bf16x8*)(QKV + (qrow0 + lc) * QKVD + hh * 64 + 32 * k + 8 * lq);
            float bm[9][4];
            attn_bias(bm, (const LAS float*)(lds + AT_BT) + hh * 132, lc, lq);
            attn_tile(lds, qf, bm, 0, false, sinks[hh], AO + qrow0 * D + hh * 64, 8, c.lane);
        }
        __syncthreads();
    }
    if (c.dry) return;
    const int gt = c.bid * 512 + tid, ngt = c.G * 512;
    for (int idx = gt; idx < 8 * 128 * 64; idx += ngt) {
        const int b = idx >> 13, jj = (idx >> 6) & 127, cc = (idx & 63) * 4;
        const bf16_t* rp = QKV + ((size_t)b * PSEQ + 3968 + jj) * QKVD + cc;
        const u32x2 kw = *(const u32x2*)(rp + 1024), vw = *(const u32x2*)(rp + 1280);
        *(f32x4*)(c.out + O_KP + (size_t)idx * 4) = (f32x4){bflo(kw.x), bfhi(kw.x), bflo(kw.y), bfhi(kw.y)};
        *(f32x4*)(c.out + O_VP + (size_t)idx * 4) = (f32x4){bflo(vw.x), bfhi(vw.x), bflo(vw.y), bfhi(vw.y)};
    }
    for (int i2 = gt; i2 < 128 * 8 * 64; i2 += ngt) {
        const int b = i2 >> 9, jj = 120 + ((i2 >> 6) & 7), cc = (i2 & 63) * 4;
        const bf16_t* rp = QKV + ((size_t)TP + (size_t)b * 8 + (jj - 120)) * QKVD + cc; const u32x2 kw = *(const u32x2*)(rp + 1024), vw = *(const u32x2*)(rp + 1280);
        const size_t o = ((size_t)b * 128 + jj) * 256 + cc;
        *(f32x4*)(c.out + O_KS + o) = (f32x4){bflo(kw.x), bfhi(kw.x), bflo(kw.y), bfhi(kw.y)}; *(f32x4*)(c.out + O_VS + o) = (f32x4){bflo(vw.x), bfhi(vw.x), bflo(vw.y), bfhi(vw.y)};
    }
}


#define XB_TMO      128
#define XB_XCNT(j)  (256  + 64 * (j))
#define XB_XSUB(j)  (1280 + 64 * (j))
#define XB_XGEN(j)  (2304 + 64 * (j))
#define XB_TOP      3328
#define XB_TOPGEN   3392
#define XCD_BAR_WORDS 3456
#define XB_SPIN_CAP (1u << 18)
__device__ __forceinline__ unsigned xb_ld(unsigned* p)              { return __hip_atomic_load(p, __ATOMIC_RELAXED, __HIP_MEMORY_SCOPE_AGENT); }
__device__ __forceinline__ unsigned xb_add(unsigned* p, unsigned v) { return __hip_atomic_fetch_add(p, v, __ATOMIC_RELAXED, __HIP_MEMORY_SCOPE_AGENT); }
__device__ __forceinline__ unsigned xb_xcc_id() { return (unsigned)__builtin_amdgcn_s_getreg((3 << 11) | 20) & 0xFu; }
#define XB_SPIN(cond, bar) do { unsigned _sp = 0; while (cond) { __builtin_amdgcn_s_sleep(1); \
    if ((++_sp & 255u) == 0u) { if (xb_ld(&(bar)[XB_TMO])) break; if (_sp > XB_SPIN_CAP) { atomicAdd(&(bar)[XB_TMO], 1u); break; } } } } while (0)
struct XcdBarrier { unsigned* bar; unsigned x; volatile LAS unsigned* st; };
__device__ __forceinline__ XcdBarrier xcd_barrier_post(unsigned* bar, volatile LAS unsigned* st) {
    XcdBarrier b; b.bar = bar; b.x = xb_xcc_id(); b.st = st;
    if (threadIdx.x == 0) (void)xb_add(&bar[XB_XCNT(b.x)], 1u);
    return b;
}
__device__ __forceinline__ void xcd_barrier_complete(unsigned* bar, unsigned x, unsigned& nloc, unsigned& nx) {
    const unsigned G = gridDim.x * gridDim.y * gridDim.z;
    unsigned sum, cnt, mine, sp = 0u;
    for (;;) {
        sum = 0u; cnt = 0u; mine = 0u;
#pragma unroll
        for (unsigned j = 0; j < 16; ++j) { const unsigned c = xb_ld(&bar[XB_XCNT(j)]); sum += c; cnt += (c > 0u) ? 1u : 0u; mine = (j == x) ? c : mine; }
        if (sum == G) break;
        __builtin_amdgcn_s_sleep(1);
        if ((++sp & 255u) == 0u) { if (xb_ld(&bar[XB_TMO])) break; if (sp > XB_SPIN_CAP) { atomicAdd(&bar[XB_TMO], 1u); break; } }
    }
    nloc = mine > 0u ? mine : 1u; nx = cnt > 0u ? cnt : 1u;
}
__device__ __forceinline__ void xcd_barrier(const XcdBarrier& b) {
    asm volatile("s_waitcnt vmcnt(0)" ::: "memory");
    __syncthreads();
    if (threadIdx.x == 0) {
        unsigned* bar = b.bar;
        __builtin_amdgcn_s_waitcnt(0);
        unsigned nloc = b.st[0], nx = b.st[1];
        if (nloc == 0u) { xcd_barrier_complete(bar, b.x, nloc, nx); b.st[0] = nloc; b.st[1] = nx; }
        const unsigned old = xb_add(&bar[XB_XSUB(b.x)], 1u);
        const unsigned gen = old / nloc;
        if (old + 1u == (gen + 1u) * nloc) {
            __builtin_amdgcn_fence(__ATOMIC_RELEASE, "agent");
            asm volatile("s_waitcnt vmcnt(0)" ::: "memory");
            const unsigned og = xb_add(&bar[XB_TOP], 1u);
            const unsigned tg = og / nx;
            if (og + 1u == (tg + 1u) * nx) xb_add(&bar[XB_TOPGEN], 1u);
            else XB_SPIN(xb_ld(&bar[XB_TOPGEN]) == tg, bar);
            __builtin_amdgcn_fence(__ATOMIC_ACQUIRE, "agent");
            xb_add(&bar[XB_XGEN(b.x)], 1u);
            asm volatile("s_waitcnt vmcnt(0)" ::: "memory");
        } else {
            XB_SPIN(xb_ld(&bar[XB_XGEN(b.x)]) == gen, bar);
            __builtin_amdgcn_fence(__ATOMIC_ACQUIRE, "agent");
            asm volatile("s_waitcnt vmcnt(0)" ::: "memory");
        }
    }
    __syncthreads();
}


#ifndef MFMA16
#define MFMA16(a, b, c) __builtin_amdgcn_mfma_f32_16x16x32_bf16((a), (b), (c), 0, 0, 0)
#endif
template <int MODE>
__device__ __forceinline__ void small_gemm_tile(const Ctx& c, const bf16_t* A, const bf16_t* Bt, int K, int tm, int tn, bf16_t* O, int ldo, const float* bias, float* pss) {
    LAS float* P = (LAS float*)c.lds;
    const int lane = c.lane, w = c.wave, q = lane >> 4, c16 = lane & 15;
    const int kw = K >> 3, nks = kw >> 5;
    f32x4 acc[4][4];
#pragma unroll
    for (int mt = 0; mt < 4; ++mt)
#pragma unroll
        for (int nt = 0; nt < 4; ++nt) acc[mt][nt] = (f32x4){0.f, 0.f, 0.f, 0.f};
    const bf16_t* ap = A + (size_t)(64 * tm + c16) * K + w * kw + 8 * q;
    const bf16_t* bp = Bt + (size_t)(64 * tn + c16) * K + w * kw + 8 * q;
#pragma unroll 4
    for (int ks = 0; ks < nks; ++ks) {
        bf16x8 af[4], bfr[4];
#pragma unroll
        for (int mt = 0; mt < 4; ++mt) af[mt] = *(const bf16x8*)(ap + (size_t)mt * 16 * K + ks * 32);
#pragma unroll
        for (int nt = 0; nt < 4; ++nt) bfr[nt] = *(const bf16x8*)(bp + (size_t)nt * 16 * K + ks * 32);
#pragma unroll
        for (int mt = 0; mt < 4; ++mt)
#pragma unroll
            for (int nt = 0; nt < 4; ++nt) acc[mt][nt] = MFMA16(af[mt], bfr[nt], acc[mt][nt]);
    }
#pragma unroll
    for (int mt = 0; mt < 4; ++mt)
#pragma unroll
        for (int nt = 0; nt < 4; ++nt)
#pragma unroll
            for (int r = 0; r < 4; ++r) P[(w * 64 + mt * 16 + 4 * q + r) * 65 + nt * 16 + c16] = acc[mt][nt][r];
    __syncthreads();
    {
        const int row = 8 * w + (lane >> 3), col0 = (lane & 7) * 8;
        float v[8];
#pragma unroll
        for (int j = 0; j < 8; ++j) v[j] = bias ? bias[64 * tn + col0 + j] : 0.f;
#pragma unroll
        for (int ww = 0; ww < 8; ++ww)
#pragma unroll
            for (int j = 0; j < 8; ++j) v[j] += P[(ww * 64 + row) * 65 + col0 + j];
        u32x4 o; o.x = cvt_pk_bf16(v[0], v[1]); o.y = cvt_pk_bf16(v[2], v[3]); o.z = cvt_pk_bf16(v[4], v[5]); o.w = cvt_pk_bf16(v[6], v[7]);
        *(u32x4*)(O + (size_t)(64 * tm + row) * ldo + 64 * tn + col0) = o;
        if (MODE == 0) {
            float ss = 0.f;
#pragma unroll
            for (int j = 0; j < 8; ++j) ss += v[j] * v[j];
            ss += __shfl_xor(ss, 1); ss += __shfl_xor(ss, 2); ss += __shfl_xor(ss, 4);
            if ((lane & 7) == 0) pss[(size_t)(64 * tm + row) * 16 + tn] = ss;
        }
    }
    __syncthreads();
}

__device__ __forceinline__ void cache_shift_copy(const Ctx& c, int vw, int nvw) {
    const float* ck = GIN(c, 4); const float* cv = GIN(c, 5);
    const int vt = vw * 64 + c.lane, nvt = nvw * 64;
    for (int i2 = vt; i2 < 128 * 120 * 64; i2 += nvt) {
        const int b = i2 / (120 * 64), rem = i2 - b * (120 * 64), jj = rem >> 6, cc = (rem & 63) * 4;
        const size_t src = ((size_t)b * 128 + jj + 8) * 256 + cc, dst = ((size_t)b * 128 + jj) * 256 + cc;
        *(f32x4*)(c.out + O_KS + dst) = *(const f32x4*)(ck + src); *(f32x4*)(c.out + O_VS + dst) = *(const f32x4*)(cv + src);
    }
}

enum { ST_P0, ST_GMOD, ST_NORM, ST_GSWI, ST_GROWS_FFN, ST_GINPROJ, ST_CONV, ST_SCAN, ST_GATE, ST_GROWS_SSM, ST_GQKV, ST_ATTN, ST_GROWS_O, ST_NOP, ST_GSLICE };
constexpr int NREAL = 25;
#ifndef GMASK
#define GMASK 0x1FFF
#endif
#ifndef NEXTRA
#define NEXTRA 0
#endif
#ifndef EXTRA_T
#define EXTRA_T
#define EXTRA_A
#endif
constexpr int NSTEPS = NREAL + NEXTRA;
__device__ const unsigned char PROG_T[NSTEPS] = { ST_P0, ST_GMOD,
    ST_NORM, ST_GSWI, ST_GROWS_FFN, ST_NORM, ST_GINPROJ, ST_CONV, ST_SCAN, ST_GATE, ST_GROWS_SSM, ST_NORM, ST_GSWI, ST_GROWS_FFN,
    ST_NORM, ST_GSWI, ST_GROWS_FFN, ST_NORM, ST_GQKV, ST_ATTN, ST_GROWS_O, ST_NORM, ST_GSWI, ST_GROWS_FFN, ST_NORM EXTRA_T };
__device__ const unsigned char PROG_A[NSTEPS] = { 0, 0,
    0, 0, 0, 1, 0, 0, 0, 0, 0, 2, 1, 1,
    3, 2, 2, 4, 0, 0, 0, 5, 3, 3, 6 EXTRA_A };

__global__ void __launch_bounds__(512, 2) hybrid_fwd(Args args) {
    extern __shared__ __attribute__((aligned(16))) unsigned char lds_raw[];
    cg::grid_group grid = cg::this_grid();
    {
        volatile LAS unsigned* st0 = (volatile LAS unsigned*)((LAS unsigned char*)lds_raw + LDS_BYTES - 64);
        if (threadIdx.x < 2) st0[threadIdx.x] = 0u;
        __syncthreads();
    }
    const XcdBarrier xbar = xcd_barrier_post((unsigned*)(GAS unsigned*)(args.ws + OFF_CTL), (volatile LAS unsigned*)((LAS unsigned char*)lds_raw + LDS_BYTES - 64));
    for (int st = 0; st < NSTEPS; ++st) {
        int tid_o = threadIdx.x; asm volatile("" : "+v"(tid_o));
        GAS unsigned char* ws1 = (GAS unsigned char*)args.ws; asm volatile("" : "+s"(ws1));
        GAS float* out1 = (GAS float*)args.out; asm volatile("" : "+s"(out1));
        unsigned char* ws_g = (unsigned char*)ws1; float* out_g = (float*)out1;
        unsigned char* ws_f = args.ws; asm volatile("" : "+s"(ws_f));
        float* out_f = args.out; asm volatile("" : "+s"(out_f));
        unsigned char* ws = ws_f; float* outp = out_f;
#define PHSEL(bit) do { if ((GMASK >> (bit)) & 1) { c.ws = ws_g; c.out = out_g; ws = ws_g; } else { c.ws = ws_f; c.out = out_f; ws = ws_f; } } while (0)
        Ctx c;
        c.lds = (LAS unsigned char*)lds_raw;
        c.tid = tid_o; c.lane = c.tid & 63; c.wave = __builtin_amdgcn_readfirstlane(c.tid >> 6);
        c.G = gridDim.x; c.bid = blockIdx.x; c.gw = c.bid * NWAVES + c.wave; c.ngw = c.G * NWAVES;
        c.in = args.in; c.out = outp; c.ws = ws; c.dry = st >= NREAL; c.out2 = out_f; c.ws2 = ws_f;
        const int ty = PROG_T[st], arg = PROG_A[st];
        switch (ty) {
        case ST_P0: PHSEL(ST_P0); p0_phase(c); break;
        case ST_GMOD: PHSEL(ST_GMOD); {
            pg8::Gemm g{(const bf16_t*)(ws + OFF_CS), (const bf16_t*)(ws + OFF_ADAT), 256, 18432, 1024};
            pg8::StaticOrder S; S.init(256, 18432, c.G, c.bid);
            EpiMod E{(float*)(ws + OFF_MOD), ((const float*)(const GAS float*)args.in[9])};
            pg8::gemm_phase<EpiMod, pg8::StaticOrder, true, true>(c.lds, g, S, E, c.tid);
            if (c.bid >= 72) p0_run(c, 20480, 1408, 26112, 3712, 0, 0, (c.bid - 72) * NWAVES + c.wave, (c.G - 72) * NWAVES);
        } break;
        case ST_NORM: PHSEL(ST_NORM); norm_phase(c, arg); break;
        case ST_GSWI: PHSEL(ST_GSWI); {
            pg8::Gemm g{(const bf16_t*)(ws + OFF_HIN), (const bf16_t*)(ws + OFF_WIN) + (size_t)arg * NFF2 * D, T, NFF2, D};
            pg8::StaticOrder S; S.init(T, NFF2, c.G, c.bid);
            EpiSwiglu E{(bf16_t*)(ws + OFF_ACT)};
            pg8::gemm_phase<EpiSwiglu, pg8::StaticOrder, true, true>(c.lds, g, S, E, c.tid);
            if (arg == 3 && c.bid >= 88 && !c.dry) cache_shift_copy(c, (c.bid - 88) * NWAVES + c.wave, (c.G - 88) * NWAVES);
            if (arg < 3 && c.bid >= 88 && !c.dry) {
                const int vw = (c.bid - 88) * NWAVES + c.wave, nvw = (c.G - 88) * NWAVES;
                if (arg == 0) p0_run(c, 12032, 2816, 21888, 1408, 0, 0, vw, nvw);
                else if (arg == 1) p0_run(c, 14848, 2816, 23296, 1408, 29824, 1280, vw, nvw);
                else p0_run(c, 17664, 2816, 24704, 1408, 0, 0, vw, nvw);
            }
        } break;
        case ST_GROWS_FFN: case ST_GROWS_SSM: case ST_GROWS_O: { PHSEL(ST_GROWS_FFN);
            const bf16_t* A0; const bf16_t* B0; int K0; const float* bias = nullptr;
            if (ty == ST_GROWS_FFN) { A0 = (const bf16_t*)(ws + OFF_ACT); B0 = (const bf16_t*)(ws + OFF_WOUT) + (size_t)arg * D * DFF; K0 = DFF; }
            else if (ty == ST_GROWS_SSM) { A0 = (const bf16_t*)(ws + OFF_Z); B0 = (const bf16_t*)(ws + OFF_SSMOUT); K0 = DIN; }
            else { A0 = (const bf16_t*)(ws + OFF_AO); B0 = (const bf16_t*)(ws + OFF_OW); K0 = D; bias = ((const float*)(const GAS float*)args.in[26]); }
#pragma unroll 1
            for (int pass = 0; pass < 2; ++pass) {
                pg8::Gemm g; pg8::StaticOrder S; float* part = nullptr;
                if (pass == 0) { const int pk = c.bid >> 4;
                    g = pg8::Gemm{A0 + (size_t)TP * K0 + (size_t)pk * 256, B0 + (size_t)pk * 256, TS, D, K0, 256};
                    S.init_slices(K0 / 256, c.G, c.bid); part = (float*)(ws + OFF_PART) + (size_t)pk * TS * D; }
                else { g = pg8::Gemm{A0, B0, TP, D, K0, 0}; S.init(TP, D, c.G, c.bid); }
                EpiRows E{(bf16_t*)(ws + OFF_F), bias, (float*)(ws + OFF_PSS), part};
                pg8::gemm_phase<EpiRows, pg8::StaticOrder, true, true>(c.lds, g, S, E, c.tid);
            }
        } break;
        case ST_GINPROJ: PHSEL(ST_GINPROJ); {
            pg8::Gemm g{(const bf16_t*)(ws + OFF_HIN), (const bf16_t*)(ws + OFF_SSMIN), T, NINP, D};
            pg8::StaticOrder S; S.init(T, NINP, c.G, c.bid);
            EpiInproj E{(bf16_t*)(ws + OFF_Z), (bf16_t*)(ws + OFF_XBC), (bf16_t*)(ws + OFF_HALO), (float*)(ws + OFF_DTS), ((const float*)(const GAS float*)args.in[17])};
            pg8::gemm_phase<EpiInproj, pg8::StaticOrder, true, true>(c.lds, g, S, E, c.tid);
        } break;
        case ST_CONV: PHSEL(ST_CONV); conv_phase(c); break;
        case ST_SCAN: PHSEL(ST_SCAN); scan_phase(c, arg); break;
        case ST_GATE: PHSEL(ST_GATE); gate_phase(c); break;
        case ST_GQKV: PHSEL(ST_GQKV); {
            pg8::Gemm g{(const bf16_t*)(ws + OFF_HIN), (const bf16_t*)(ws + OFF_QKVW), TP, QKVD, D};
            for (int t = c.bid; t < 384; t += c.G)
                small_gemm_tile<1>(c, g.A + (size_t)TP * D, g.Bt, D, t / 24, t % 24, (bf16_t*)(ws + OFF_QKV) + (size_t)TP * QKVD, QKVD, ((const float*)(const GAS float*)args.in[23]), nullptr);
            pg8::StaticOrder S; S.init(TP, QKVD, c.G, c.bid);
            EpiQkv E{(bf16_t*)(ws + OFF_QKV), ((const float*)(const GAS float*)args.in[23])};
            pg8::gemm_phase<EpiQkv, pg8::StaticOrder, true, true>(c.lds, g, S, E, c.tid);
        } break;
        case ST_ATTN: PHSEL(ST_ATTN); attn_phase(c, arg); break;
        default: break;
        }
        if (st + 1 < NSTEPS) { if (st == 0) grid.sync(); else xcd_barrier(xbar); }
    }
}

extern "C" void kernel_launch(void* const* d_in, const int* in_sizes, int n_in, void* d_out, int out_size, void* d_ws, size_t ws_size, hipStream_t stream) {
    static int grid = 0;
    if (grid == 0) {
        if (n_in != 28 || ws_size < WS_NEED) { fprintf(stderr, "kernel_launch: unexpected n_in %d or ws_size %zu (need %zu)\n", n_in, ws_size, (size_t)WS_NEED); grid = -1; return; }
        int dev = 0, cus = 0, per_cu = 0;
        hipGetDevice(&dev);
        hipDeviceGetAttribute(&cus, hipDeviceAttributeMultiprocessorCount, dev);
        if (hipFuncSetAttribute((const void*)hybrid_fwd, hipFuncAttributeMaxDynamicSharedMemorySize, LDS_BYTES) != hipSuccess) { fprintf(stderr, "kernel_launch: hipFuncSetAttribute failed\n"); grid = -1; return; }
        if (hipOccupancyMaxActiveBlocksPerMultiprocessor(&per_cu, (const void*)hybrid_fwd, 512, LDS_BYTES) != hipSuccess || per_cu < 1) { fprintf(stderr, "kernel_launch: occupancy query gave %d\n", per_cu); per_cu = 1; }
        (void)hipGetLastError();
        grid = cus * (per_cu > 1 ? 1 : per_cu);
    }
    if (grid < 0) return;
    Args a{};
    for (int i = 0; i < 28; ++i) a.in[i] = (const float*)d_in[i];
    a.out = (float*)d_out; a.ws = (unsigned char*)d_ws;
    if (hipMemsetAsync((char*)d_ws + OFF_CTL, 0, CTL_BYTES, stream) != hipSuccess) { fprintf(stderr, "kernel_launch: memset failed\n"); return; }
    void* kargs[] = {&a};
    hipError_t e = hipLaunchCooperativeKernel((const void*)hybrid_fwd, dim3(grid), dim3(512), kargs, LDS_BYTES, stream);
    if (e != hipSuccess) fprintf(stderr, "kernel_launch: cooperative launch failed: %s (grid %d)\n", hipGetErrorString(e), grid);
}
```

```cpp
#include <hip/hip_runtime.h>
#include <hip/hip_cooperative_groups.h>
#include <cstdio>
#include <cstdint>
namespace cg = cooperative_groups;

#define LAS __attribute__((address_space(3)))
#define GAS __attribute__((address_space(1)))
#define GIN(c_, i_) ((const float*)(const GAS float*)((c_).in[i_]))
typedef unsigned short bf16_t;
typedef short bf16x8 __attribute__((ext_vector_type(8)));
typedef float f32x4 __attribute__((ext_vector_type(4)));
typedef float f32x2 __attribute__((ext_vector_type(2)));
typedef unsigned u32x4 __attribute__((ext_vector_type(4)));
typedef unsigned u32x2 __attribute__((ext_vector_type(2)));

constexpr int D = 1024, TP = 32768, TS = 1024, T = TP + TS, NSEQ = 136, PSEQ = 4096, SSEQ = 8;
constexpr int DFF = 2816, NFF2 = 5632;
constexpr int DIN = 2048, CONVD = 3072, NH = 32, NINP = 5376, NIN_REAL = 5152;
constexpr int QKVD = 1536;
constexpr float EPS = 1e-6f;
constexpr int NCHUNK = T / 128;

constexpr size_t OFF_CTL = 0, CTL_BYTES = 16384;
constexpr size_t OFF_CS = CTL_BYTES;
constexpr size_t OFF_MOD = OFF_CS + 256 * 1024 * 2;
constexpr size_t OFF_PSS = OFF_MOD + (size_t)2 * NSEQ * 9216 * 4;
constexpr size_t OFF_DTS = OFF_PSS + (size_t)T * 16 * 4;
constexpr size_t OFF_ACS = OFF_DTS + (size_t)T * 32 * 4;
constexpr size_t OFF_HALO = OFF_ACS + (size_t)T * 32 * 4;
constexpr size_t OFF_WIN = OFF_HALO + (size_t)NCHUNK * 3 * CONVD * 2;
constexpr size_t OFF_WOUT = OFF_WIN + (size_t)4 * NFF2 * D * 2;
constexpr size_t OFF_SSMIN = OFF_WOUT + (size_t)4 * D * DFF * 2;
constexpr size_t OFF_SSMOUT = OFF_SSMIN + (size_t)NINP * D * 2;
constexpr size_t OFF_QKVW = OFF_SSMOUT + (size_t)D * DIN * 2;
constexpr size_t OFF_OW = OFF_QKVW + (size_t)QKVD * D * 2;
constexpr size_t OFF_HIN = OFF_OW + (size_t)D * D * 2;
constexpr size_t OFF_R = OFF_HIN + (size_t)T * D * 2;
constexpr size_t R_BYTES = (size_t)T * 5120 * 2;
constexpr size_t WS_NEED = OFF_R + R_BYTES;
static_assert(WS_NEED <= 536870912ull, "workspace map must fit 512 MiB");
constexpr size_t OFF_ACT = OFF_R;
constexpr size_t OFF_F = OFF_R + (size_t)T * DFF * 2;
constexpr size_t OFF_Z = OFF_R;
constexpr size_t OFF_XBC = OFF_R + (size_t)T * DIN * 2;
constexpr size_t OFF_QKV = OFF_R;
constexpr size_t OFF_AO = OFF_R + (size_t)T * QKVD * 2;
constexpr size_t OFF_ADAT = OFF_R;
constexpr size_t OFF_PART = OFF_F + (size_t)T * D * 2;
static_assert(OFF_PART + (size_t)11 * TS * D * 4 <= OFF_R + R_BYTES, "partials overlay");
static_assert(OFF_AO + (size_t)T * D * 2 <= OFF_F, "swa overlay");
static_assert(OFF_F + (size_t)T * D * 2 <= OFF_R + R_BYTES, "F overlay");
static_assert(OFF_F >= OFF_Z + (size_t)T * DIN * 2, "F must not overlap yn");

constexpr size_t O_Y = 0;
constexpr size_t O_SSMP = (size_t)T * D;
constexpr size_t O_CONVP = O_SSMP + (size_t)8 * 32 * 64 * 128;
constexpr size_t O_KP = O_CONVP + (size_t)8 * 3 * CONVD;
constexpr size_t O_VP = O_KP + (size_t)8 * 128 * 256;
constexpr size_t O_SSMS = O_VP + (size_t)8 * 128 * 256;
constexpr size_t O_CONVS = O_SSMS + (size_t)128 * 32 * 64 * 128;
constexpr size_t O_KS = O_CONVS + (size_t)128 * 3 * CONVD;
constexpr size_t O_VS = O_KS + (size_t)128 * 128 * 256;

constexpr int LDS_BYTES = 147456;
constexpr int NWAVES = 8;

__device__ __forceinline__ unsigned f2bf(float f) { unsigned u = __builtin_bit_cast(unsigned, f); return (u + 0x7fffu + ((u >> 16) & 1u)) >> 16; }
__device__ __forceinline__ unsigned pk2(float lo, float hi) { return f2bf(lo) | (f2bf(hi) << 16); }
typedef __bf16 bf16x2_t __attribute__((ext_vector_type(2)));
__device__ __forceinline__ unsigned cvt_pk_bf16(float lo, float hi) { f32x2 v = {lo, hi}; bf16x2_t b = __builtin_convertvector(v, bf16x2_t); return __builtin_bit_cast(unsigned, b); }
__device__ __forceinline__ float bflo(unsigned w) { return __uint_as_float(w << 16); }
__device__ __forceinline__ float bfhi(unsigned w) { return __uint_as_float(w & 0xffff0000u); }
__device__ __forceinline__ float bf1(bf16_t b) { return __uint_as_float((unsigned)b << 16); }
__device__ __forceinline__ float silu_f(float g) { return g * __builtin_amdgcn_rcpf(1.0f + __expf(-g)); }
__device__ __forceinline__ float wave_sum(float v) {
#pragma unroll
    for (int o = 1; o < 64; o <<= 1) v += __shfl_xor(v, o);
    return v;
}
__device__ __forceinline__ int seq_of(int row) { return row < TP ? (row >> 12) : 8 + ((row - TP) >> 3); }

namespace pg8 {
#define PG8_LAS __attribute__((address_space(3)))
constexpr int BM = 256, BK = 64, HALF = 128, HTB = HALF * BK * 2, STAGE_BYTES = 8 * HTB, NXCD = 8, WGM = 8;
__host__ __device__ __forceinline__ int lds_byte(int r, int c) { const int st = (r >> 4) * 2 + (c >> 5), rr = r & 15, cc = c & 31, ob = rr * 64 + cc * 2; return st * 1024 + (ob ^ (((ob >> 9) & 1) << 5)); }
__host__ __device__ __forceinline__ void stage_rc(int b, int& R, int& C) { const int st = b / 1024, sb = b % 1024, swz = sb ^ (((sb >> 9) & 1) << 5); R = (st >> 1) * 16 + swz / 64; C = (st & 1) * 32 + (swz % 64) / 2; }
__host__ __device__ __forceinline__ int perm32(int rho) { const int n = rho >> 4, i = rho & 15; return 8 * (i >> 2) + 4 * n + (i & 3); }
struct Unit { int pm, pn; };
struct Gemm { const bf16_t* A; const bf16_t* Bt; int M, N, K; int Kloop; };
struct StaticOrder {
    int nM, nN, nwg, G, c, sl;
    __host__ __device__ void init(int M, int N, int G_, int c_) { nM = M / BM; nN = N / BM; nwg = nM * nN; G = G_; c = c_; sl = 0; }
    __host__ __device__ void init_slices(int S, int G_, int c_) { nM = 4; nN = 4; nwg = 16 * S; G = G_; c = c_; sl = 1; }
    __host__ __device__ bool next(int i, Unit& u) const {
        const long L = (long)i * G + c; if (L >= nwg) return false;
        if (sl) { if (i > 0) return false; u.pm = ((int)L & 15) >> 2; u.pn = (int)L & 3; return true; }
        int wgid = (int)L; { const int q = nwg / NXCD, r = nwg % NXCD, xcd = wgid % NXCD, off = wgid / NXCD; wgid = (xcd < r ? xcd * (q + 1) : r * (q + 1) + (xcd - r) * q) + off; }
        const int nig = WGM * nN, gid = wgid / nig, fm = gid * WGM, gsz = (nM - fm) < WGM ? (nM - fm) : WGM;
        u.pm = fm + ((wgid % nig) % gsz); u.pn = (wgid % nig) / gsz; return true;
    }
    __device__ __forceinline__ void a_ready(const Unit&) const {}
    __device__ __forceinline__ void done(const Unit&) const {}
};

template <class Epi, class Sched, bool ALIGN_EPI = false, bool SP2 = false>
__device__ __forceinline__ void gemm_phase(PG8_LAS unsigned char* lds, const Gemm g, const Sched& S, const Epi& E, const int tid) {
    const int wid = __builtin_amdgcn_readfirstlane(tid >> 6), lane = tid & 63, wr = wid >> 2, wc = wid & 3, fr = lane & 15, fq = lane >> 4;
    const int K = g.K, nt = (g.Kloop ? g.Kloop : g.K) / BK;
    unsigned voffA[2], voffB[2];
#pragma unroll
    for (int i = 0; i < 2; ++i) { int R, C; stage_rc(tid * 16 + i * 8192, R, C); const int Rb = Epi::PERM ? ((R & ~31) + perm32(R & 31)) : R;
        voffA[i] = (unsigned)(R * K + C) * 2u; voffB[i] = (unsigned)(Rb * K + C) * 2u; }
    const size_t kstep = (size_t)(BK * 2);
    const size_t hstep = (size_t)HALF * K * 2;
    const size_t tstep = 2 * hstep;
    const unsigned ldsw = (unsigned)wid * 1024u;
    const int aoff = lds_byte(wr * 64 + fr, fq * 8), boff = lds_byte(wc * 32 + fr, fq * 8);
#define PG8_SA(b, h) (((b) * 2 + (h)) * HTB)
#define PG8_SB(b, h) ((4 + (b) * 2 + (h)) * HTB)
#define PG8_STAGE(bufoff, gbase, voff) do { _Pragma("unroll") for (int _i = 0; _i < 2; ++_i) \
        __builtin_amdgcn_global_load_lds((const unsigned*)((const char*)(gbase) + (voff)[_i]), (PG8_LAS unsigned*)(lds + (bufoff) + ldsw + _i * 8192), 16, 0, 0); } while (0)
#define PG8_LDA(dst, b, h) do { _Pragma("unroll") for (int m = 0; m < 4; ++m) _Pragma("unroll") for (int k = 0; k < 2; ++k) dst[m][k] = *(const PG8_LAS bf16x8*)(lds + PG8_SA(b, h) + aoff + m * 2048 + k * 1024); } while (0)
#define PG8_LDB(dst, b, h) do { _Pragma("unroll") for (int n = 0; n < 2; ++n) _Pragma("unroll") for (int k = 0; k < 2; ++k) dst[n][k] = *(const PG8_LAS bf16x8*)(lds + PG8_SB(b, h) + boff + n * 2048 + k * 1024); } while (0)
#define PG8_MMA(ai, bj, At, Bt) do { __builtin_amdgcn_s_setprio(1); _Pragma("unroll") for (int m = 0; m < 4; ++m) _Pragma("unroll") for (int n = 0; n < 2; ++n) _Pragma("unroll") for (int k = 0; k < 2; ++k) \
        acc[ai][bj][m][n] = __builtin_amdgcn_mfma_f32_16x16x32_bf16(Bt[n][k], At[m][k], acc[ai][bj][m][n], 0, 0, 0); __builtin_amdgcn_s_setprio(0); } while (0)
#define PG8_WAIT_V(n) asm volatile("s_waitcnt vmcnt(" #n ")" ::: "memory")
#define PG8_WAIT_L(n) asm volatile("s_waitcnt lgkmcnt(" #n ")" ::: "memory")
#define PG8_BAR __builtin_amdgcn_s_barrier()
#define PG8_SCHED __builtin_amdgcn_sched_barrier(0)
    Unit cur, nxt; int ui = 0;
    if (!S.next(0, cur)) return;
    f32x4 acc[2][2][4][2];
#pragma unroll
    for (int a = 0; a < 2; ++a)
#pragma unroll
        for (int b = 0; b < 2; ++b)
#pragma unroll
            for (int m = 0; m < 4; ++m)
#pragma unroll
                for (int n = 0; n < 2; ++n) acc[a][b][m][n] = (f32x4){0.f, 0.f, 0.f, 0.f};
    bf16x8 At[4][2], B0[2][2], B1[2][2];
    const char* cA = (const char*)g.A + (size_t)cur.pm * tstep; const char* cB = (const char*)g.Bt + (size_t)cur.pn * tstep;
    S.a_ready(cur);
    if constexpr (SP2) {
        PG8_STAGE(PG8_SB(0, 0), cB, voffB); PG8_STAGE(PG8_SB(0, 1), cB + hstep, voffB); PG8_STAGE(PG8_SA(0, 0), cA, voffA); PG8_STAGE(PG8_SA(0, 1), cA + hstep, voffA);
        if (wr == 1) PG8_BAR;
        PG8_WAIT_V(2); PG8_BAR;
        PG8_STAGE(PG8_SB(1, 0), cB + kstep, voffB); PG8_STAGE(PG8_SA(1, 0), cA + kstep, voffA); PG8_STAGE(PG8_SB(1, 1), cB + hstep + kstep, voffB);
        PG8_WAIT_V(6); PG8_BAR;
    } else {
        PG8_STAGE(PG8_SB(0, 0), cB, voffB); PG8_STAGE(PG8_SA(0, 0), cA, voffA); PG8_STAGE(PG8_SB(0, 1), cB + hstep, voffB); PG8_STAGE(PG8_SA(0, 1), cA + hstep, voffA);
        if (wr == 1) PG8_BAR;
        PG8_WAIT_V(4); PG8_BAR;
        PG8_STAGE(PG8_SB(1, 0), cB + kstep, voffB); PG8_STAGE(PG8_SA(1, 0), cA + kstep, voffA); PG8_STAGE(PG8_SB(1, 1), cB + hstep + kstep, voffB);
        PG8_WAIT_V(6); PG8_BAR;
    }
    for (;;) {
        const bool has_next = S.next(ui + 1, nxt);
        const char* nA = has_next ? (const char*)g.A + (size_t)nxt.pm * tstep : cA; const char* nB = has_next ? (const char*)g.Bt + (size_t)nxt.pn * tstep : cB;
        for (int t = 0; t < nt; t += 2) {
            const bool last = (t == nt - 2);
            const char* a1 = cA + (size_t)(t + 1) * kstep;
            const char* a2 = last ? nA : cA + (size_t)(t + 2) * kstep; const char* b2 = last ? nB : cB + (size_t)(t + 2) * kstep;
            const char* a3 = a2 + kstep; const char* b3 = b2 + kstep;
            if (last && has_next) S.a_ready(nxt);
            if constexpr (SP2) {
            PG8_LDB(B0, 0, 0); PG8_LDB(B1, 0, 1); PG8_SCHED; PG8_LDA(At, 0, 0); PG8_STAGE(PG8_SA(1, 1), a1 + hstep, voffA);
            PG8_WAIT_V(8); PG8_WAIT_L(0); PG8_BAR; PG8_MMA(0, 0, At, B0); PG8_MMA(0, 1, At, B1); PG8_BAR; PG8_SCHED;
            PG8_LDA(At, 0, 1); PG8_STAGE(PG8_SB(0, 0), b2, voffB); PG8_STAGE(PG8_SB(0, 1), b2 + hstep, voffB); PG8_STAGE(PG8_SA(0, 0), a2, voffA);
            PG8_WAIT_V(8); PG8_WAIT_L(0); PG8_BAR; PG8_MMA(1, 0, At, B0); PG8_MMA(1, 1, At, B1); PG8_BAR; PG8_SCHED;
            PG8_LDB(B0, 1, 0); PG8_LDB(B1, 1, 1); PG8_SCHED; PG8_LDA(At, 1, 0); PG8_STAGE(PG8_SA(0, 1), a2 + hstep, voffA);
            PG8_WAIT_V(8); PG8_WAIT_L(0); PG8_BAR; PG8_MMA(0, 0, At, B0); PG8_MMA(0, 1, At, B1); PG8_BAR; PG8_SCHED;
            PG8_LDA(At, 1, 1); PG8_STAGE(PG8_SB(1, 0), b3, voffB); PG8_STAGE(PG8_SB(1, 1), b3 + hstep, voffB); PG8_STAGE(PG8_SA(1, 0), a3, voffA);
            PG8_WAIT_V(8); PG8_WAIT_L(0); PG8_BAR; PG8_MMA(1, 0, At, B0); PG8_MMA(1, 1, At, B1); PG8_BAR; PG8_SCHED;
            } else {
            PG8_LDB(B0, 0, 0); PG8_SCHED; PG8_LDA(At, 0, 0); PG8_STAGE(PG8_SA(1, 1), a1 + hstep, voffA);
            PG8_WAIT_L(8); PG8_BAR; PG8_WAIT_L(0); PG8_MMA(0, 0, At, B0); PG8_BAR; PG8_SCHED;
            PG8_LDB(B1, 0, 1); PG8_STAGE(PG8_SB(0, 0), b2, voffB);
            PG8_BAR; PG8_WAIT_L(0); PG8_MMA(0, 1, At, B1); PG8_BAR;
            PG8_LDA(At, 0, 1); PG8_STAGE(PG8_SA(0, 0), a2, voffA);
            PG8_BAR; PG8_WAIT_L(0); PG8_MMA(1, 0, At, B0); PG8_BAR; PG8_SCHED;
            PG8_STAGE(PG8_SB(0, 1), b2 + hstep, voffB);
            PG8_WAIT_V(6); PG8_BAR; PG8_MMA(1, 1, At, B1); PG8_BAR;
            PG8_LDB(B0, 1, 0); PG8_SCHED; PG8_LDA(At, 1, 0); PG8_STAGE(PG8_SA(0, 1), a2 + hstep, voffA);
            PG8_WAIT_L(8); PG8_BAR; PG8_WAIT_L(0); PG8_MMA(0, 0, At, B0); PG8_BAR; PG8_SCHED;
            PG8_LDB(B1, 1, 1); PG8_STAGE(PG8_SB(1, 0), b3, voffB);
            PG8_BAR; PG8_WAIT_L(0); PG8_MMA(0, 1, At, B1); PG8_BAR;
            PG8_LDA(At, 1, 1); PG8_STAGE(PG8_SA(1, 0), a3, voffA);
            PG8_BAR; PG8_WAIT_L(0); PG8_MMA(1, 0, At, B0); PG8_BAR; PG8_SCHED;
            PG8_STAGE(PG8_SB(1, 1), b3 + hstep, voffB);
            PG8_WAIT_V(6); PG8_BAR; PG8_MMA(1, 1, At, B1); PG8_BAR;
            }
        }
        if constexpr (ALIGN_EPI) { if (wr == 0) PG8_BAR; }
        E(acc, cur, wr, wc, fr, fq);
        if (!has_next) break;
#pragma unroll
        for (int a = 0; a < 2; ++a)
#pragma unroll
            for (int b = 0; b < 2; ++b)
#pragma unroll
                for (int m = 0; m < 4; ++m)
#pragma unroll
                    for (int n = 0; n < 2; ++n) acc[a][b][m][n] = (f32x4){0.f, 0.f, 0.f, 0.f};
        cur = nxt; cA = nA; cB = nB; ++ui;
        if constexpr (ALIGN_EPI) { if (wr == 1) PG8_BAR; }
    }
    PG8_WAIT_V(0);
    if constexpr (!ALIGN_EPI) { if (wr == 0) PG8_BAR; }
    PG8_BAR;
#undef PG8_SA
#undef PG8_SB
#undef PG8_STAGE
#undef PG8_LDA
#undef PG8_LDB
#undef PG8_MMA
#undef PG8_WAIT_V
#undef PG8_WAIT_L
#undef PG8_BAR
#undef PG8_SCHED
}
}

typedef f32x4 AccT[2][2][4][2];

struct EpiSwiglu {
    static constexpr bool PERM = true;
    bf16_t* O;
    __device__ __forceinline__ void operator()(const AccT& acc, const pg8::Unit& u, int wr, int wc, int fr, int fq) const {
        const int row0 = u.pm * 256 + wr * 64 + fr, col0 = u.pn * 128 + wc * 32 + 8 * fq;
#pragma unroll
        for (int ai = 0; ai < 2; ++ai)
#pragma unroll
            for (int m = 0; m < 4; ++m) {
                bf16_t* p = O + (size_t)(row0 + ai * 128 + m * 16) * DFF + col0;
                const f32x4 g0 = acc[ai][0][m][0], g1 = acc[ai][0][m][1], u0 = acc[ai][1][m][0], u1 = acc[ai][1][m][1];
                u32x4 w;
                w.x = cvt_pk_bf16(silu_f(g0[0]) * u0[0], silu_f(g0[1]) * u0[1]); w.y = cvt_pk_bf16(silu_f(g0[2]) * u0[2], silu_f(g0[3]) * u0[3]);
                w.z = cvt_pk_bf16(silu_f(g1[0]) * u1[0], silu_f(g1[1]) * u1[1]); w.w = cvt_pk_bf16(silu_f(g1[2]) * u1[2], silu_f(g1[3]) * u1[3]);
                *(u32x4*)p = w;
            }
    }
};
struct EpiRows {
    static constexpr bool PERM = true;
    bf16_t* O; const float* bias; float* pss; float* part;
    __device__ __forceinline__ void operator()(const AccT& acc, const pg8::Unit& u, int wr, int wc, int fr, int fq) const {
        const int row0 = u.pm * 256 + wr * 64 + fr, col0 = u.pn * 256 + wc * 32 + 8 * fq;
        if (part) {
            float* rp = part + (size_t)row0 * D + col0;
#pragma unroll
            for (int ai = 0; ai < 2; ++ai) {
#pragma unroll
                for (int m = 0; m < 4; ++m) {
#pragma unroll
                    for (int bj = 0; bj < 2; ++bj) { *(f32x4*)(rp + bj * 128) = acc[ai][bj][m][0]; *(f32x4*)(rp + bj * 128 + 4) = acc[ai][bj][m][1]; }
                    rp += 16 * D;
                }
                rp += 64 * D;
            }
            return;
        }
        f32x4 bv[2][2];
#pragma unroll
        for (int bj = 0; bj < 2; ++bj)
#pragma unroll
            for (int n = 0; n < 2; ++n) bv[bj][n] = bias ? *(const f32x4*)(bias + col0 + bj * 128 + 4 * n) : (f32x4){0.f, 0.f, 0.f, 0.f};
#pragma unroll
        for (int ai = 0; ai < 2; ++ai)
#pragma unroll
            for (int m = 0; m < 4; ++m) {
                const int row = row0 + ai * 128 + m * 16;
                float ss = 0.f;
#pragma unroll
                for (int bj = 0; bj < 2; ++bj) {
                    const f32x4 v0 = acc[ai][bj][m][0] + bv[bj][0], v1 = acc[ai][bj][m][1] + bv[bj][1];
                    ss += (v0[0] * v0[0] + v0[1] * v0[1]) + (v0[2] * v0[2] + v0[3] * v0[3]) + (v1[0] * v1[0] + v1[1] * v1[1]) + (v1[2] * v1[2] + v1[3] * v1[3]);
                    u32x4 w; w.x = cvt_pk_bf16(v0[0], v0[1]); w.y = cvt_pk_bf16(v0[2], v0[3]); w.z = cvt_pk_bf16(v1[0], v1[1]); w.w = cvt_pk_bf16(v1[2], v1[3]);
                    *(u32x4*)(O + (size_t)row * D + col0 + bj * 128) = w;
                }
                ss += __shfl_xor(ss, 16); ss += __shfl_xor(ss, 32);
                if (fq == 0) pss[(size_t)row * 16 + u.pn * 4 + wc] = ss;
            }
    }
};
struct EpiMod {
    static constexpr bool PERM = true;
    float* O; const float* bias;
    __device__ __forceinline__ void operator()(const AccT& acc, const pg8::Unit& u, int wr, int wc, int fr, int fq) const {
        const int row0 = u.pm * 256 + wr * 64 + fr, col0 = u.pn * 256 + wc * 32 + 8 * fq;
#pragma unroll
        for (int ai = 0; ai < 2; ++ai)
#pragma unroll
            for (int m = 0; m < 4; ++m) {
                const int row = row0 + ai * 128 + m * 16;
                if (row < NSEQ) {
#pragma unroll
                    for (int bj = 0; bj < 2; ++bj) {
                        const int c = col0 + bj * 128; const int l = c / 9216, cc = c - l * 9216;
                        float* p = O + ((size_t)l * NSEQ + row) * 9216 + cc;
                        *(f32x4*)p = acc[ai][bj][m][0] + *(const f32x4*)(bias + c);
                        *(f32x4*)(p + 4) = acc[ai][bj][m][1] + *(const f32x4*)(bias + c + 4);
                    }
                }
            }
    }
};
struct EpiInproj {
    static constexpr bool PERM = true;
    bf16_t* Z; bf16_t* XBC; bf16_t* HALO; float* DTS; const float* dt_bias;
    __device__ __forceinline__ void operator()(const AccT& acc, const pg8::Unit& u, int wr, int wc, int fr, int fq) const {
        const int row0 = u.pm * 256 + wr * 64 + fr, col0 = u.pn * 256 + wc * 32 + 8 * fq;
        if (u.pn == 20) {
            if (wc == 0) {
                const f32x4 b0 = *(const f32x4*)(dt_bias + 8 * fq), b1 = *(const f32x4*)(dt_bias + 8 * fq + 4);
#pragma unroll
                for (int ai = 0; ai < 2; ++ai)
#pragma unroll
                    for (int m = 0; m < 4; ++m) {
                        const int row = row0 + ai * 128 + m * 16;
                        f32x4 v0 = acc[ai][0][m][0] + b0, v1 = acc[ai][0][m][1] + b1;
#pragma unroll
                        for (int e = 0; e < 4; ++e) { v0[e] = v0[e] > 20.f ? v0[e] : log1pf(__expf(v0[e])); v1[e] = v1[e] > 20.f ? v1[e] : log1pf(__expf(v1[e])); }
                        *(f32x4*)(DTS + (size_t)row * 32 + 8 * fq) = v0; *(f32x4*)(DTS + (size_t)row * 32 + 8 * fq + 4) = v1;
                    }
            }
            return;
        }
        const bool isz = u.pn < 8;
        bf16_t* base = isz ? Z : XBC; const int ld = isz ? DIN : CONVD; const int cb = isz ? col0 : col0 - DIN;
#pragma unroll
        for (int ai = 0; ai < 2; ++ai)
#pragma unroll
            for (int m = 0; m < 4; ++m) {
                const int row = row0 + ai * 128 + m * 16;
#pragma unroll
                for (int bj = 0; bj < 2; ++bj) {
                    const f32x4 v0 = acc[ai][bj][m][0], v1 = acc[ai][bj][m][1];
                    u32x4 w; w.x = cvt_pk_bf16(v0[0], v0[1]); w.y = cvt_pk_bf16(v0[2], v0[3]); w.z = cvt_pk_bf16(v1[0], v1[1]); w.w = cvt_pk_bf16(v1[2], v1[3]);
                    *(u32x4*)(base + (size_t)row * ld + cb + bj * 128) = w;
                    if (!isz && (row & 127) >= 125) *(u32x4*)(HALO + ((size_t)(row >> 7) * 3 + ((row & 127) - 125)) * CONVD + cb + bj * 128) = w;
                }
            }
    }
};
struct EpiQkv {
    static constexpr bool PERM = true;
    bf16_t* O; const float* bias;
    __device__ __forceinline__ void operator()(const AccT& acc, const pg8::Unit& u, int wr, int wc, int fr, int fq) const {
        const int row0 = u.pm * 256 + wr * 64 + fr, col0 = u.pn * 256 + wc * 32 + 8 * fq;
        f32x4 bv[2][2];
#pragma unroll
        for (int bj = 0; bj < 2; ++bj)
#pragma unroll
            for (int n = 0; n < 2; ++n) bv[bj][n] = *(const f32x4*)(bias + col0 + bj * 128 + 4 * n);
#pragma unroll
        for (int ai = 0; ai < 2; ++ai)
#pragma unroll
            for (int m = 0; m < 4; ++m) {
                const int row = row0 + ai * 128 + m * 16;
#pragma unroll
                for (int bj = 0; bj < 2; ++bj) {
                    const f32x4 v0 = acc[ai][bj][m][0] + bv[bj][0], v1 = acc[ai][bj][m][1] + bv[bj][1];
                    u32x4 w; w.x = cvt_pk_bf16(v0[0], v0[1]); w.y = cvt_pk_bf16(v0[2], v0[3]); w.z = cvt_pk_bf16(v1[0], v1[1]); w.w = cvt_pk_bf16(v1[2], v1[3]);
                    *(u32x4*)(O + (size_t)row * QKVD + col0 + bj * 128) = w;
                }
            }
    }
};

struct Args { const float* in[28]; float* out; unsigned char* ws; };

struct Ctx {
    LAS unsigned char* lds;
    int tid, lane, wave, gw, ngw, G, bid;
    const float* const* in;
    float* out; unsigned char* ws; bool dry;
    float* out2; unsigned char* ws2;
};

__device__ __forceinline__ void p0_item(const float* W, int N, int K, bf16_t* WT, int dest_row0, int src_col0, int k0, LAS float* scr, int lane) {
    if (src_col0 >= 0) {
        float wv[32];
#pragma unroll
        for (int i = 0; i < 32; ++i) wv[i] = W[(size_t)(k0 + 2 * i + (lane >> 5)) * N + src_col0 + (lane & 31)];
#pragma unroll
        for (int i = 0; i < 32; ++i) scr[(2 * i + (lane >> 5)) * 33 + (lane & 31)] = wv[i];
    } else {
#pragma unroll 8
        for (int i = 0; i < 32; ++i) { const int kk = 2 * i + (lane >> 5); scr[kk * 33 + (lane & 31)] = 0.f; }
    }
    asm volatile("s_waitcnt lgkmcnt(0)" ::: "memory");
    const int c = lane & 7;
#pragma unroll
    for (int j = 0; j < 4; ++j) { const int n = (lane >> 3) + 8 * j; const LAS float* s = scr + (8 * c) * 33 + n;
        u32x4 o; o.x = cvt_pk_bf16(s[0 * 33], s[1 * 33]); o.y = cvt_pk_bf16(s[2 * 33], s[3 * 33]); o.z = cvt_pk_bf16(s[4 * 33], s[5 * 33]); o.w = cvt_pk_bf16(s[6 * 33], s[7 * 33]);
        *(u32x4*)(WT + (size_t)(dest_row0 + n) * K + k0 + 8 * c) = o; }
    asm volatile("s_waitcnt lgkmcnt(0)" ::: "memory");
}
__device__ __forceinline__ void p0_run(const Ctx& c, int lo1, int n1, int lo2, int n2, int lo3, int n3, int vw, int nvw) {
    LAS float* scr = (LAS float*)(c.lds + c.wave * 16384);
    constexpr int I_ADA = 2 * 16 * 288, I_WIN = 4 * 16 * 176, I_WOUT = 4 * 44 * 32, I_SIN = 16 * 168, I_SOUT = 32 * 32, I_QKV = 16 * 48, I_O = 16 * 32;
    for (int v = vw; v < n1 + n2 + n3; v += nvw) {
        int r = v < n1 ? lo1 + v : (v < n1 + n2 ? lo2 + (v - n1) : lo3 + (v - n1 - n2));
        if (r < I_ADA) { const int l = r / 4608, rr = r % 4608, kb = rr / 288, nb = rr % 288;
            p0_item(GIN(c, 8) + (size_t)l * 1024 * 9216, 9216, 1024, (bf16_t*)(c.ws + OFF_ADAT), l * 9216 + nb * 32, nb * 32, kb * 64, scr, c.lane); continue; } r -= I_ADA;
        if (r < I_WIN) { const int f = r / 2816, rr = r % 2816, kb = rr / 176, nb = rr % 176; const int d0 = nb * 32, pn = d0 >> 8, bj = (d0 >> 7) & 1, cc = d0 & 127;
            p0_item(GIN(c, 12) + (size_t)f * 1024 * NFF2, NFF2, 1024, (bf16_t*)(c.ws + OFF_WIN) + (size_t)f * NFF2 * 1024, d0, bj * DFF + pn * 128 + cc, kb * 64, scr, c.lane); continue; } r -= I_WIN;
        if (r < I_WOUT) { const int f = r / 1408, rr = r % 1408, kb = rr / 32, nb = rr % 32;
            p0_item(GIN(c, 13) + (size_t)f * DFF * 1024, 1024, DFF, (bf16_t*)(c.ws + OFF_WOUT) + (size_t)f * 1024 * DFF, nb * 32, nb * 32, kb * 64, scr, c.lane); continue; } r -= I_WOUT;
        if (r < I_SIN) { const int kb = r / 168, nb = r % 168;
            p0_item(GIN(c, 14), NIN_REAL, 1024, (bf16_t*)(c.ws + OFF_SSMIN), nb * 32, nb < 161 ? nb * 32 : -1, kb * 64, scr, c.lane); continue; } r -= I_SIN;
        if (r < I_SOUT) { const int kb = r / 32, nb = r % 32;
            p0_item(GIN(c, 21), 1024, DIN, (bf16_t*)(c.ws + OFF_SSMOUT), nb * 32, nb * 32, kb * 64, scr, c.lane); continue; } r -= I_SOUT;
        if (r < I_QKV) { const int kb = r / 48, nb = r % 48;
            p0_item(GIN(c, 22), QKVD, 1024, (bf16_t*)(c.ws + OFF_QKVW), nb * 32, nb * 32, kb * 64, scr, c.lane); continue; } r -= I_QKV;
        { const int kb = r / 32, nb = r % 32;
            p0_item(GIN(c, 25), 1024, 1024, (bf16_t*)(c.ws + OFF_OW), nb * 32, nb * 32, kb * 64, scr, c.lane); }
    }
}
__device__ __forceinline__ void p0_phase(const Ctx& c) {
    p0_run(c, 0, 9216, 0, 0, 0, 0, c.gw, c.ngw);
    bf16_t* CS = (bf16_t*)(c.ws + OFF_CS);
    for (int row = c.gw; row < 256; row += c.ngw) {
        const float* src = row < 8 ? GIN(c, 6) + (size_t)row * D : (row < NSEQ ? GIN(c, 7) + (size_t)(row - 8) * D : nullptr);
#pragma unroll
        for (int j = 0; j < 4; ++j) {
            f32x4 v = src ? *(const f32x4*)(src + 4 * (c.lane + 64 * j)) : (f32x4){0.f, 0.f, 0.f, 0.f};
            if (src) { v[0] = silu_f(v[0]); v[1] = silu_f(v[1]); v[2] = silu_f(v[2]); v[3] = silu_f(v[3]); }
            u32x2 w; w.x = pk2(v[0], v[1]); w.y = pk2(v[2], v[3]);
            *(u32x2*)(CS + (size_t)row * D + 4 * (c.lane + 64 * j)) = w;
        }
    }
}

struct NormRow { f32x4 v[4]; u32x2 xb[4]; u32x2 f[4]; float p; };
__device__ __forceinline__ void norm_load(NormRow& r, const float* xin, const bf16_t* F, const float* PSS, int row, int lane, bool has_upd, bool xf32) {
    if (xf32) {
#pragma unroll
        for (int j = 0; j < 4; ++j) r.v[j] = *(const f32x4*)(xin + 4 * (lane + 64 * j));
    } else {
#pragma unroll
        for (int j = 0; j < 4; ++j) r.xb[j] = *(const u32x2*)((const bf16_t*)xin + 4 * (lane + 64 * j));
    }
    if (has_upd) {
#pragma unroll
        for (int j = 0; j < 4; ++j) r.f[j] = *(const u32x2*)(F + (size_t)row * D + 4 * (lane + 64 * j));
        r.p = PSS[(size_t)row * 16 + (lane & 15)];
    }
}
__device__ __forceinline__ void norm_phase(const Ctx& c, int s) {
    const bool has_upd = s > 0, has_out = s < 6, xf32 = s <= 1;
    const int sp = s > 0 ? s - 1 : 0, lp = sp / 3, subp = sp % 3, l = has_out ? s / 3 : 0, sub = has_out ? s % 3 : 0;
    const float coef = (subp == 1) ? 1.0f : 0.5f;
    const float* MOD = (const float*)(c.ws + OFF_MOD);
    const float* PSS = (const float*)(c.ws + OFF_PSS);
    const bf16_t* F = (const bf16_t*)(c.ws + OFF_F);
    bf16_t* HIN = (bf16_t*)(c.ws + OFF_HIN);
    const float* post = GIN(c, 11) + (size_t)(lp * 3 + subp) * D;
    const float* pre = GIN(c, 10) + (size_t)(l * 3 + sub) * D;
    float* xo = c.dry ? (float*)(c.ws + OFF_XBC) : c.out;
    const int lane = c.lane;
    f32x4 gp[4], am[4], sh[4];
    int cur_seq = -1;
#define NORM_PARAMS(seq_) do { if ((seq_) != cur_seq) { cur_seq = (seq_); \
        const float* gate_ = MOD + ((size_t)lp * NSEQ + (seq_)) * 9216 + subp * 3072 + 2048; \
        const float* shift_ = MOD + ((size_t)l * NSEQ + (seq_)) * 9216 + sub * 3072; \
        _Pragma("unroll") for (int j = 0; j < 4; ++j) { const int col = 4 * (lane + 64 * j); \
            if (has_upd) gp[j] = *(const f32x4*)(gate_ + col) * *(const f32x4*)(post + col) * coef; \
            if (has_out) { sh[j] = *(const f32x4*)(shift_ + col); am[j] = *(const f32x4*)(pre + col) * (*(const f32x4*)(shift_ + 1024 + col) + 1.0f); } } } } while (0)
#define NORM_BODY(row_, v, fv, rf) do { \
        if (has_upd) { _Pragma("unroll") for (int j = 0; j < 4; ++j) { v[j] = v[j] + gp[j] * fv[j] * (rf); \
                if (has_out) { u32x2 w_; w_.x = cvt_pk_bf16(v[j][0], v[j][1]); w_.y = cvt_pk_bf16(v[j][2], v[j][3]); *(u32x2*)((bf16_t*)(xo + (size_t)(row_) * D) + 4 * (lane + 64 * j)) = w_; } \
                else *(f32x4*)(xo + (size_t)(row_) * D + 4 * (lane + 64 * j)) = v[j]; } } \
        if (has_out) { float ss_ = 0.f; \
            _Pragma("unroll") for (int j = 0; j < 4; ++j) ss_ += (v[j][0] * v[j][0] + v[j][1] * v[j][1]) + (v[j][2] * v[j][2] + v[j][3] * v[j][3]); \
            const float rs_ = rsqrtf(wave_sum(ss_) * (1.0f / D) + EPS); \
            _Pragma("unroll") for (int j = 0; j < 4; ++j) { const f32x4 o_ = v[j] * am[j] * rs_ + sh[j]; \
                u32x2 w_; w_.x = cvt_pk_bf16(o_[0], o_[1]); w_.y = cvt_pk_bf16(o_[2], o_[3]); *(u32x2*)(HIN + (size_t)(row_) * D + 4 * (lane + 64 * j)) = w_; } } } while (0)
    const int rb = (int)((long)c.gw * TP / c.ngw), re = (int)((long)(c.gw + 1) * TP / c.ngw);
    if (rb < re) {
        NormRow nx[2];
#pragma unroll
        for (int k = 0; k < 2; ++k) { nx[k].p = 0.f;
#pragma unroll
            for (int j = 0; j < 4; ++j) { nx[k].f[j].x = 0u; nx[k].f[j].y = 0u; nx[k].xb[j].x = 0u; nx[k].xb[j].y = 0u; nx[k].v[j] = (f32x4){0.f, 0.f, 0.f, 0.f}; } }
#define NORM_XIN(r_) (xf32 ? GIN(c, 0) + (size_t)(r_) * D : c.out + (size_t)(r_) * D)
        norm_load(nx[0], NORM_XIN(rb), F, PSS, rb, lane, has_upd, xf32);
        if (rb + 1 < re) norm_load(nx[1], NORM_XIN(rb + 1), F, PSS, rb + 1, lane, has_upd, xf32);
        for (int row0 = rb; row0 < re; row0 += 2) {
            NormRow cu[2];
            cu[0] = nx[0]; cu[1] = nx[1];
            if (row0 + 2 < re) norm_load(nx[0], NORM_XIN(row0 + 2), F, PSS, row0 + 2, lane, has_upd, xf32);
            if (row0 + 3 < re) norm_load(nx[1], NORM_XIN(row0 + 3), F, PSS, row0 + 3, lane, has_upd, xf32);
#pragma unroll
            for (int k = 0; k < 2; ++k) {
                const int row = row0 + k;
                if (row < re) {
                    NORM_PARAMS(row >> 12);
                    f32x4 v[4], fv[4]; float rf = 0.f;
#pragma unroll
                    for (int j = 0; j < 4; ++j) { v[j] = xf32 ? cu[k].v[j] : (f32x4){bflo(cu[k].xb[j].x), bfhi(cu[k].xb[j].x), bflo(cu[k].xb[j].y), bfhi(cu[k].xb[j].y)};
                        fv[j] = (f32x4){bflo(cu[k].f[j].x), bfhi(cu[k].f[j].x), bflo(cu[k].f[j].y), bfhi(cu[k].f[j].y)}; }
                    if (has_upd) { float p = cu[k].p; p += __shfl_xor(p, 1); p += __shfl_xor(p, 2); p += __shfl_xor(p, 4); p += __shfl_xor(p, 8); rf = rsqrtf(p * (1.0f / D) + EPS); }
                    NORM_BODY(row, v, fv, rf);
                }
            }
        }
#undef NORM_XIN
    }
    {
        const int nsl = (subp != 1) ? DFF / 256 : (lp == 0 ? DIN / 256 : D / 256);
        const float* obias = (subp == 1 && lp == 1) ? GIN(c, 26) : nullptr;
        const float* PART = (const float*)(c.ws + OFF_PART);
        for (int rs = c.gw; rs < TS; rs += c.ngw) {
            const int row = TP + rs;
            f32x4 v[4], fv[4]; float rf = 0.f;
            if (xf32) {
#pragma unroll
                for (int j = 0; j < 4; ++j) v[j] = *(const f32x4*)(GIN(c, 1) + (size_t)rs * D + 4 * (lane + 64 * j));
            } else {
#pragma unroll
                for (int j = 0; j < 4; ++j) { const u32x2 xb = *(const u32x2*)((const bf16_t*)(c.out + (size_t)row * D) + 4 * (lane + 64 * j)); v[j] = (f32x4){bflo(xb.x), bfhi(xb.x), bflo(xb.y), bfhi(xb.y)}; }
            }
#pragma unroll
            for (int j = 0; j < 4; ++j) fv[j] = (f32x4){0.f, 0.f, 0.f, 0.f};
            if (has_upd) {
#pragma unroll
                for (int j = 0; j < 4; ++j) if (obias) fv[j] = *(const f32x4*)(obias + 4 * (lane + 64 * j));
                for (int k0 = 0; k0 < nsl; k0 += 4) {
                    f32x4 t[4][4];
#pragma unroll
                    for (int kk = 0; kk < 4; ++kk)
#pragma unroll
                        for (int j = 0; j < 4; ++j) t[kk][j] = (k0 + kk < nsl) ? *(const f32x4*)(PART + ((size_t)(k0 + kk) * TS + rs) * D + 4 * (lane + 64 * j)) : (f32x4){0.f, 0.f, 0.f, 0.f};
#pragma unroll
                    for (int kk = 0; kk < 4; ++kk)
#pragma unroll
                        for (int j = 0; j < 4; ++j) fv[j] = fv[j] + t[kk][j];
                }
                float ss = 0.f;
#pragma unroll
                for (int j = 0; j < 4; ++j) ss += (fv[j][0] * fv[j][0] + fv[j][1] * fv[j][1]) + (fv[j][2] * fv[j][2] + fv[j][3] * fv[j][3]);
                rf = rsqrtf(wave_sum(ss) * (1.0f / D) + EPS);
            }
            NORM_PARAMS(8 + (rs >> 3));
            NORM_BODY(row, v, fv, rf);
        }
    }
#undef NORM_PARAMS
#undef NORM_BODY
}

__device__ __forceinline__ void conv_phase(const Ctx& c) {
    bf16_t* XBC = (bf16_t*)(c.ws + OFF_XBC);
    const bf16_t* HALO = (const bf16_t*)(c.ws + OFF_HALO);
    const float* cw = GIN(c, 15); const float* cbias = GIN(c, 16); const float* sconv = GIN(c, 3);
    constexpr int NCONV = NCHUNK * 12, NACS = NCHUNK / 2;
    float* cso = c.dry ? (float*)(c.ws + OFF_HIN) : c.out + O_CONVS; float* cpo = c.dry ? (float*)(c.ws + OFF_HIN) + 2097152 : c.out + O_CONVP;
    for (int it = c.gw; it < NCONV + NACS; it += c.ngw) {
        if (it < NCONV) {
            const int ck = it / 12, sl = it % 12, ch = sl * 256 + c.lane * 4;
            const f32x4 w0 = *(const f32x4*)(cw + ch), w1 = *(const f32x4*)(cw + CONVD + ch), w2 = *(const f32x4*)(cw + 2 * CONVD + ch), w3 = *(const f32x4*)(cw + 3 * CONVD + ch);
            const f32x4 bb = *(const f32x4*)(cbias + ch);
            const bool samp = ck >= 256;
            f32x4 h0 = (f32x4){0.f, 0.f, 0.f, 0.f}, h1 = h0, h2 = h0;
            if (!samp && (ck & 31) != 0) {
                const bf16_t* hp = HALO + (size_t)(ck - 1) * 3 * CONVD + ch;
                const u32x2 a = *(const u32x2*)hp, b = *(const u32x2*)(hp + CONVD), d = *(const u32x2*)(hp + 2 * CONVD);
                h0 = (f32x4){bflo(a.x), bfhi(a.x), bflo(a.y), bfhi(a.y)}; h1 = (f32x4){bflo(b.x), bfhi(b.x), bflo(b.y), bfhi(b.y)}; h2 = (f32x4){bflo(d.x), bfhi(d.x), bflo(d.y), bfhi(d.y)};
            }
            const bool lastp = !samp && (ck & 31) == 31;
            for (int t0 = 0; t0 < 128; t0 += 16) {
                const size_t rbase = (size_t)ck * 128 + t0;
                u32x2 raw[16];
#pragma unroll
                for (int i = 0; i < 16; ++i) raw[i] = *(const u32x2*)(XBC + (rbase + i) * CONVD + ch);
                f32x4 sh[2][3];
                int sq = 0;
                if (samp) {
                    sq = (ck - 256) * 16 + (t0 >> 3);
#pragma unroll
                    for (int hf = 0; hf < 2; ++hf) { const float* sp = sconv + (size_t)(sq + hf) * 3 * CONVD + ch;
                        sh[hf][0] = *(const f32x4*)sp; sh[hf][1] = *(const f32x4*)(sp + CONVD); sh[hf][2] = *(const f32x4*)(sp + 2 * CONVD); }
                }
#pragma unroll
                for (int i = 0; i < 16; ++i) {
                    if (samp && (i & 7) == 0) { h0 = sh[i >> 3][0]; h1 = sh[i >> 3][1]; h2 = sh[i >> 3][2]; }
                    const f32x4 x = (f32x4){bflo(raw[i].x), bfhi(raw[i].x), bflo(raw[i].y), bfhi(raw[i].y)};
                    f32x4 o = w0 * h0 + w1 * h1 + w2 * h2 + w3 * x + bb;
                    o[0] = silu_f(o[0]); o[1] = silu_f(o[1]); o[2] = silu_f(o[2]); o[3] = silu_f(o[3]);
                    u32x2 w; w.x = cvt_pk_bf16(o[0], o[1]); w.y = cvt_pk_bf16(o[2], o[3]);
                    *(u32x2*)(XBC + (rbase + i) * CONVD + ch) = w;
                    if (samp) { if ((i & 7) >= 5) *(f32x4*)(cso + ((size_t)(sq + (i >> 3)) * 3 + ((i & 7) - 5)) * CONVD + ch) = x; }
                    else if (lastp && t0 == 112 && i >= 13) *(f32x4*)(cpo + ((size_t)(ck >> 5) * 3 + (i - 13)) * CONVD + ch) = x;
                    h0 = h1; h1 = h2; h2 = x;
                }
            }
        } else {
            const int ck = (it - NCONV) * 2 + (c.lane >> 5), h = c.lane & 31;
            const float A = -__expf(GIN(c, 18)[h]);
            const float* DTS = (const float*)(c.ws + OFF_DTS); float* ACS = (float*)(c.ws + OFF_ACS);
            const bool samp = ck >= 256;
            float cum = 0.f;
            for (int t0 = 0; t0 < 128; t0 += 8) {
                float d[8];
#pragma unroll
                for (int i = 0; i < 8; ++i) d[i] = DTS[((size_t)ck * 128 + t0 + i) * 32 + h];
                if (samp) cum = 0.f;
#pragma unroll
                for (int i = 0; i < 8; ++i) { cum += d[i] * A; ACS[((size_t)ck * 128 + t0 + i) * 32 + h] = cum; }
            }
        }
    }
}

constexpr int SROW = 272, XROW = 144;
constexpr int SC_C = 0, SC_B = 34816, SC_BS = 69632, SC_X = 104448, SC_H = 122880, SC_F = 140288;
static_assert(SC_F + 1024 <= LDS_BYTES - 64, "scan LDS");
#define MFMA16(a, b, c) __builtin_amdgcn_mfma_f32_16x16x32_bf16((a), (b), (c), 0, 0, 0)
typedef short v4i16_t __attribute__((ext_vector_type(4)));
__device__ __forceinline__ u32x2 tr_read(LAS unsigned char* p) { return __builtin_bit_cast(u32x2, __builtin_amdgcn_ds_read_tr16_b64_v4i16((LAS v4i16_t*)p)); }
__device__ __forceinline__ bf16x8 tr_frag(LAS unsigned char* img, int rs, int kb, int nb, int lane) {
    const int g = lane >> 4, qq = (lane >> 2) & 3, pp = lane & 3;
    LAS unsigned char* a = img + (kb + 8 * g + qq) * rs + (nb + 4 * pp) * 2;
    const u32x2 lo = tr_read(a), hi = tr_read(a + 4 * rs);
    u32x4 v; v.x = lo.x; v.y = lo.y; v.z = hi.x; v.w = hi.y;
    return __builtin_bit_cast(bf16x8, v);
}

__device__ __forceinline__ void scan_prompt_unit(const Ctx& c, int b, int h) {
    LAS unsigned char* lds = c.lds;
    const int tid = c.tid, lane = c.lane, w = c.wave, q = lane >> 4, c16 = lane & 15, g = h >> 3;
    bf16_t* XBC = (bf16_t*)(c.ws + OFF_XBC);
    const float* DTS = (const float*)(c.ws + OFF_DTS); const float* ACS = (const float*)(c.ws + OFF_ACS);
    const float Dh = GIN(c, 19)[h];
    LAS float* acsL = (LAS float*)(lds + SC_F); LAS float* dtL = acsL + 128;
    f32x4 hacc[4];
#pragma unroll
    for (int pt = 0; pt < 4; ++pt) hacc[pt] = (f32x4){0.f, 0.f, 0.f, 0.f};
    for (int i = tid; i < 64 * SROW / 4; i += 512) ((LAS unsigned*)(lds + SC_H))[i] = 0u;
    u32x4 pc[4], pb[4], px[2]; float pdt[4], pac[4], pa_last, pa_mine = 0.f, pd_mine = 0.f;
    const int prow = tid >> 4, pcc = tid & 15, xrow = tid >> 3, xcc = tid & 7;
#define SCAN_LOAD(ck_) do { const size_t r0_ = (size_t)b * PSEQ + (size_t)(ck_) * 128; \
        _Pragma("unroll") for (int i = 0; i < 4; ++i) { const bf16_t* rp = XBC + (r0_ + prow + 32 * i) * CONVD + g * 128 + pcc * 8; pc[i] = *(const u32x4*)(rp + 2560); pb[i] = *(const u32x4*)(rp + 2048); \
            pdt[i] = DTS[(r0_ + prow + 32 * i) * 32 + h]; pac[i] = ACS[(r0_ + prow + 32 * i) * 32 + h]; } \
        _Pragma("unroll") for (int i = 0; i < 2; ++i) px[i] = *(const u32x4*)(XBC + (r0_ + xrow + 64 * i) * CONVD + h * 64 + xcc * 8); \
        pa_last = ACS[(r0_ + 127) * 32 + h]; \
        if (tid < 128) { pa_mine = ACS[(r0_ + tid) * 32 + h]; pd_mine = DTS[(r0_ + tid) * 32 + h]; } } while (0)
    SCAN_LOAD(0);
    __syncthreads();
    for (int ck = 0; ck < 32; ++ck) {
        const size_t r0 = (size_t)b * PSEQ + (size_t)ck * 128;
        asm volatile("s_waitcnt vmcnt(0)" : "+v"(pa_last), "+v"(pa_mine), "+v"(pd_mine), "+v"(pdt[0]), "+v"(pdt[1]), "+v"(pdt[2]), "+v"(pdt[3]), "+v"(pac[0]), "+v"(pac[1]), "+v"(pac[2]), "+v"(pac[3]) :: "memory");
        asm volatile("" : "+v"(pc[0]), "+v"(pc[1]), "+v"(pc[2]), "+v"(pc[3]), "+v"(pb[0]), "+v"(pb[1]), "+v"(pb[2]), "+v"(pb[3]), "+v"(px[0]), "+v"(px[1]));
        const float acs_last = pa_last;
        if (tid < 128) { acsL[tid] = pa_mine; dtL[tid] = pd_mine; }
#pragma unroll
        for (int i = 0; i < 4; ++i) {
            const int row = prow + 32 * i;
            *(LAS u32x4*)(lds + SC_C + row * SROW + pcc * 16) = pc[i];
            *(LAS u32x4*)(lds + SC_B + row * SROW + pcc * 16) = pb[i];
            const float cf = pdt[i] * __expf(acs_last - pac[i]);
            u32x4 sb; sb.x = cvt_pk_bf16(bflo(pb[i].x) * cf, bfhi(pb[i].x) * cf); sb.y = cvt_pk_bf16(bflo(pb[i].y) * cf, bfhi(pb[i].y) * cf);
            sb.z = cvt_pk_bf16(bflo(pb[i].z) * cf, bfhi(pb[i].z) * cf); sb.w = cvt_pk_bf16(bflo(pb[i].w) * cf, bfhi(pb[i].w) * cf);
            *(LAS u32x4*)(lds + SC_BS + row * SROW + pcc * 16) = sb;
        }
#pragma unroll
        for (int i = 0; i < 2; ++i) *(LAS u32x4*)(lds + SC_X + (xrow + 64 * i) * XROW + xcc * 16) = px[i];
        __syncthreads();
        if (ck + 1 < 32) SCAN_LOAD(ck + 1);
        bf16x8 cf[4];
#pragma unroll
        for (int k = 0; k < 4; ++k) cf[k] = *(const LAS bf16x8*)(lds + SC_C + (16 * w + c16) * SROW + (32 * k + 8 * q) * 2);
        f32x4 cb[8];
#pragma unroll
        for (int st = 0; st < 8; ++st) {
            cb[st] = (f32x4){0.f, 0.f, 0.f, 0.f};
            if (st <= w) {
#pragma unroll
                for (int k = 0; k < 4; ++k) { const bf16x8 bf = *(const LAS bf16x8*)(lds + SC_B + (16 * st + c16) * SROW + (32 * k + 8 * q) * 2); cb[st] = MFMA16(bf, cf[k], cb[st]); }
            }
        }
        f32x4 yo[4];
#pragma unroll
        for (int pt = 0; pt < 4; ++pt) {
            yo[pt] = (f32x4){0.f, 0.f, 0.f, 0.f};
#pragma unroll
            for (int k = 0; k < 4; ++k) { const bf16x8 hf = *(const LAS bf16x8*)(lds + SC_H + (16 * pt + c16) * SROW + (32 * k + 8 * q) * 2); yo[pt] = MFMA16(hf, cf[k], yo[pt]); }
        }
        bf16x8 xf[2][4];
        {
            const float cdec = __expf(acs_last);
#pragma unroll
            for (int pt = 0; pt < 4; ++pt) hacc[pt] = hacc[pt] * cdec;
#pragma unroll
            for (int kl = 0; kl < 4; ++kl) {
                const bf16x8 btf = tr_frag(lds + SC_BS, SROW, 32 * kl, 16 * w, lane);
#pragma unroll
                for (int pt = 0; pt < 4; ++pt) {
                    const bf16x8 x_ = tr_frag(lds + SC_X, XROW, 32 * kl, 16 * pt, lane);
                    if (kl < 2) xf[kl][pt] = x_;
                    hacc[pt] = MFMA16(btf, x_, hacc[pt]);
                }
            }
        }
        __syncthreads();
        {
            const int l = 16 * w + c16; const float acs_l = acsL[l];
#pragma unroll
            for (int st = 0; st < 8; ++st) {
                if (st <= (w | 1)) {
                    u32x2 pk; pk.x = 0u; pk.y = 0u;
                    if (st <= w) {
                        const f32x4 as = *(const LAS f32x4*)(acsL + 16 * st + 4 * q), ds = *(const LAS f32x4*)(dtL + 16 * st + 4 * q);
                        float v[4];
#pragma unroll
                        for (int r = 0; r < 4; ++r) { const int s_ = 16 * st + 4 * q + r; const float e = __expf(acs_l - as[r]) * ds[r] * cb[st][r]; v[r] = (s_ <= l) ? e : 0.f; }
                        pk.x = cvt_pk_bf16(v[0], v[1]); pk.y = cvt_pk_bf16(v[2], v[3]);
                    }
                    *(LAS u32x2*)(lds + SC_B + l * SROW + (16 * st + 4 * q) * 2) = pk;
                }
            }
        }
        f32x4 yd[4];
#pragma unroll
        for (int pt = 0; pt < 4; ++pt) yd[pt] = (f32x4){0.f, 0.f, 0.f, 0.f};
#pragma unroll
        for (int ks = 0; ks < 4; ++ks) {
            if (ks <= (w >> 1)) {
                const bf16x8 wf = *(const LAS bf16x8*)(lds + SC_B + (16 * w + c16) * SROW + (32 * ks + 8 * q) * 2);
#pragma unroll
                for (int pt = 0; pt < 4; ++pt) { const bf16x8 x_ = (ks < 2) ? xf[ks & 1][pt] : tr_frag(lds + SC_X, XROW, 32 * ks, 16 * pt, lane); yd[pt] = MFMA16(x_, wf, yd[pt]); }
            }
        }
        {
            const int l = 16 * w + c16;
            const float el = __expf(acsL[l]);
#pragma unroll
            for (int pt = 0; pt < 4; ++pt) {
                const u32x2 xr = *(const LAS u32x2*)(lds + SC_X + l * XROW + (16 * pt + 4 * q) * 2);
                const float y0 = yd[pt][0] + el * yo[pt][0] + Dh * bflo(xr.x), y1 = yd[pt][1] + el * yo[pt][1] + Dh * bfhi(xr.x);
                const float y2 = yd[pt][2] + el * yo[pt][2] + Dh * bflo(xr.y), y3 = yd[pt][3] + el * yo[pt][3] + Dh * bfhi(xr.y);
                u32x2 o; o.x = cvt_pk_bf16(y0, y1); o.y = cvt_pk_bf16(y2, y3);
                *(u32x2*)(XBC + (r0 + l) * CONVD + h * 64 + 16 * pt + 4 * q) = o;
            }
        }
#pragma unroll
        for (int pt = 0; pt < 4; ++pt) { u32x2 pk; pk.x = cvt_pk_bf16(hacc[pt][0], hacc[pt][1]); pk.y = cvt_pk_bf16(hacc[pt][2], hacc[pt][3]);
            *(LAS u32x2*)(lds + SC_H + (16 * pt + c16) * SROW + (16 * w + 4 * q) * 2) = pk; }
        __syncthreads();
    }
#undef SCAN_LOAD
    float* sp = (c.dry ? (float*)(c.ws + OFF_HIN) : c.out + O_SSMP) + (size_t)(b * 32 + h) * 64 * 128;
#pragma unroll
    for (int pt = 0; pt < 4; ++pt) *(f32x4*)(sp + (size_t)(16 * pt + c16) * 128 + 16 * w + 4 * q) = hacc[pt];
}

__device__ __forceinline__ bf16x8 tr_frag8(LAS unsigned char* img, int rs, int nb, int lane) {
    const int qq = (lane >> 2) & 3, pp = lane & 3;
    LAS unsigned char* a = img + qq * rs + (nb + 4 * pp) * 2;
    const u32x2 lo = tr_read(a), hi = tr_read(a + 4 * rs);
    u32x4 v; const bool z = lane >= 16;
    v.x = z ? 0u : lo.x; v.y = z ? 0u : lo.y; v.z = z ? 0u : hi.x; v.w = z ? 0u : hi.y;
    return __builtin_bit_cast(bf16x8, v);
}
__device__ __forceinline__ void scan_sample_wave(const Ctx& c, int bs, int h) {
    constexpr int W_C = 0, W_B = 4352, W_BS = 8704, W_X = 10880, W_F = 12032;
    LAS unsigned char* L = c.lds + c.wave * 16384;
    LAS float* acsL = (LAS float*)(L + W_F); LAS float* dtL = acsL + 8;
    const int lane = c.lane, q = lane >> 4, c16 = lane & 15, g = h >> 3, l8 = lane >> 3, ch = lane & 7;
    bf16_t* XBC = (bf16_t*)(c.ws + OFF_XBC);
    const float* DTS = (const float*)(c.ws + OFF_DTS); const float* ACS = (const float*)(c.ws + OFF_ACS);
    const size_t r0 = (size_t)TP + (size_t)bs * 8;
    const float Dh = GIN(c, 19)[h];
    {
        const bf16_t* rp = XBC + (r0 + l8) * CONVD;
        const u32x4 b0 = *(const u32x4*)(rp + 2048 + g * 128 + ch * 16), b1 = *(const u32x4*)(rp + 2048 + g * 128 + ch * 16 + 8);
        const u32x4 c0 = *(const u32x4*)(rp + 2560 + g * 128 + ch * 16), c1 = *(const u32x4*)(rp + 2560 + g * 128 + ch * 16 + 8);
        const u32x4 xv = *(const u32x4*)(rp + h * 64 + ch * 8);
        const float dtl = DTS[(r0 + l8) * 32 + h], acl = ACS[(r0 + l8) * 32 + h], a7 = ACS[(r0 + 7) * 32 + h];
        const float cf = dtl * __expf(a7 - acl);
        asm volatile("s_waitcnt lgkmcnt(0)" ::: "memory");
        *(LAS u32x4*)(L + W_C + l8 * SROW + ch * 32) = c0; *(LAS u32x4*)(L + W_C + l8 * SROW + ch * 32 + 16) = c1;
        *(LAS u32x4*)(L + W_B + l8 * SROW + ch * 32) = b0; *(LAS u32x4*)(L + W_B + l8 * SROW + ch * 32 + 16) = b1;
        u32x4 s0, s1;
        s0.x = cvt_pk_bf16(bflo(b0.x) * cf, bfhi(b0.x) * cf); s0.y = cvt_pk_bf16(bflo(b0.y) * cf, bfhi(b0.y) * cf); s0.z = cvt_pk_bf16(bflo(b0.z) * cf, bfhi(b0.z) * cf); s0.w = cvt_pk_bf16(bflo(b0.w) * cf, bfhi(b0.w) * cf);
        s1.x = cvt_pk_bf16(bflo(b1.x) * cf, bfhi(b1.x) * cf); s1.y = cvt_pk_bf16(bflo(b1.y) * cf, bfhi(b1.y) * cf); s1.z = cvt_pk_bf16(bflo(b1.z) * cf, bfhi(b1.z) * cf); s1.w = cvt_pk_bf16(bflo(b1.w) * cf, bfhi(b1.w) * cf);
        *(LAS u32x4*)(L + W_BS + l8 * SROW + ch * 32) = s0; *(LAS u32x4*)(L + W_BS + l8 * SROW + ch * 32 + 16) = s1;
        *(LAS u32x4*)(L + W_X + l8 * XROW + ch * 16) = xv;
        if (lane < 8) { acsL[lane] = ACS[(r0 + lane) * 32 + h]; dtL[lane] = DTS[(r0 + lane) * 32 + h]; }
        asm volatile("s_waitcnt lgkmcnt(0)" ::: "memory");
    }
    const float a7 = acsL[7], cdec = __expf(a7);
    bf16x8 wf;
    {
        f32x4 cbt = (f32x4){0.f, 0.f, 0.f, 0.f};
#pragma unroll
        for (int k = 0; k < 4; ++k) {
            const bf16x8 a = *(const LAS bf16x8*)(L + W_B + c16 * SROW + (32 * k + 8 * q) * 2), b = *(const LAS bf16x8*)(L + W_C + c16 * SROW + (32 * k + 8 * q) * 2);
            cbt = MFMA16(a, b, cbt);
        }
        const int l = c16 & 7; const float acs_l = acsL[l];
        float wv[4];
#pragma unroll
        for (int r = 0; r < 4; ++r) { const int s_ = (4 * q + r) & 7; const float e = __expf(acs_l - acsL[s_]) * dtL[s_] * cbt[r]; wv[r] = (q < 2 && c16 < 8 && s_ <= l) ? e : 0.f; }
        const unsigned w0 = cvt_pk_bf16(wv[0], wv[1]), w1 = cvt_pk_bf16(wv[2], wv[3]);
        const unsigned h0_ = __shfl_down(w0, 16), h1_ = __shfl_down(w1, 16);
        u32x4 v; const bool z = lane >= 16;
        v.x = z ? 0u : w0; v.y = z ? 0u : w1; v.z = z ? 0u : h0_; v.w = z ? 0u : h1_;
        wf = __builtin_bit_cast(bf16x8, v);
    }
    float el[4];
#pragma unroll
    for (int r = 0; r < 4; ++r) el[r] = __expf(acsL[(4 * q + r) & 7]);
    const float* h0base = GIN(c, 2) + (size_t)(bs * 32 + h) * 64 * 128;
    float* hobase = (c.dry ? (float*)(c.ws + OFF_Z) : c.out + O_SSMS) + (size_t)(bs * 32 + h) * 64 * 128;
#pragma unroll 1
    for (int pb = 0; pb < 4; ++pb) {
        const int p = 16 * pb + c16;
        f32x4 h0[8];
#pragma unroll
        for (int nt = 0; nt < 8; ++nt) h0[nt] = *(const f32x4*)(h0base + (size_t)p * 128 + 16 * nt + 4 * q);
        const bf16x8 xsf = tr_frag8(L + W_X, XROW, 16 * pb, lane);
        f32x4 yd = MFMA16(wf, xsf, ((f32x4){0.f, 0.f, 0.f, 0.f}));
        f32x4 yo = (f32x4){0.f, 0.f, 0.f, 0.f};
#pragma unroll
        for (int a = 0; a < 4; ++a) {
            const u32x2 clo = *(const LAS u32x2*)(L + W_C + c16 * SROW + (32 * a + 4 * q) * 2), chi = *(const LAS u32x2*)(L + W_C + c16 * SROW + (32 * a + 16 + 4 * q) * 2);
            u32x4 av; av.x = clo.x; av.y = clo.y; av.z = chi.x; av.w = chi.y;
            u32x4 bv; bv.x = cvt_pk_bf16(h0[2 * a][0], h0[2 * a][1]); bv.y = cvt_pk_bf16(h0[2 * a][2], h0[2 * a][3]); bv.z = cvt_pk_bf16(h0[2 * a + 1][0], h0[2 * a + 1][1]); bv.w = cvt_pk_bf16(h0[2 * a + 1][2], h0[2 * a + 1][3]);
            yo = MFMA16(__builtin_bit_cast(bf16x8, av), __builtin_bit_cast(bf16x8, bv), yo);
        }
        {
            const u32x2 xr = tr_read(L + W_X + (4 * (q & 1) + ((lane >> 2) & 3)) * XROW + (16 * pb + 4 * (lane & 3)) * 2);
            const float xs[4] = {bflo(xr.x), bfhi(xr.x), bflo(xr.y), bfhi(xr.y)};
            if (q < 2) {
#pragma unroll
                for (int r = 0; r < 4; ++r) { const float y = yd[r] + el[r] * yo[r] + Dh * xs[r]; XBC[(r0 + 4 * q + r) * CONVD + h * 64 + p] = (bf16_t)f2bf(y); }
            }
        }
#pragma unroll
        for (int nt = 0; nt < 8; ++nt) {
            const bf16x8 bsf = tr_frag8(L + W_BS, SROW, 16 * nt, lane);
            const f32x4 S = MFMA16(bsf, xsf, ((f32x4){0.f, 0.f, 0.f, 0.f}));
            *(f32x4*)(hobase + (size_t)p * 128 + 16 * nt + 4 * q) = h0[nt] * cdec + S;
        }
    }
}
__device__ __forceinline__ void scan_phase(const Ctx& c, int mode) {
    if (mode != 2) for (int u = c.bid; u < 256; u += c.G) scan_prompt_unit(c, u >> 5, u & 31);
    if (mode != 1) for (int u = c.gw; u < 4096; u += c.ngw) scan_sample_wave(c, u >> 5, u & 31);
}

__device__ __forceinline__ void gate_phase(const Ctx& c) {
    const bf16_t* XBC = (const bf16_t*)(c.ws + OFF_XBC); bf16_t* Z = (bf16_t*)(c.ws + OFF_Z);
    const float* nw = GIN(c, 20);
    constexpr int NIT = T * 4, U = 4;
    for (int it0 = c.gw; it0 < NIT; it0 += U * c.ngw) {
        u32x4 yv[U], zv[U];
#pragma unroll
        for (int u = 0; u < U; ++u) {
            const int it = it0 + u * c.ngw;
            if (it < NIT) { const int row = it >> 2, col = (it & 3) * 512 + c.lane * 8;
                yv[u] = *(const u32x4*)(XBC + (size_t)row * CONVD + col); zv[u] = *(const u32x4*)(Z + (size_t)row * DIN + col); }
            else { yv[u] = (u32x4){0u, 0u, 0u, 0u}; zv[u] = yv[u]; }
        }
#pragma unroll
        for (int u = 0; u < U; ++u) {
            const int it = it0 + u * c.ngw;
            if (it < NIT) {
                const int row = it >> 2, col = (it & 3) * 512 + c.lane * 8;
                float y[8] = {bflo(yv[u].x), bfhi(yv[u].x), bflo(yv[u].y), bfhi(yv[u].y), bflo(yv[u].z), bfhi(yv[u].z), bflo(yv[u].w), bfhi(yv[u].w)};
                const float z[8] = {bflo(zv[u].x), bfhi(zv[u].x), bflo(zv[u].y), bfhi(zv[u].y), bflo(zv[u].z), bfhi(zv[u].z), bflo(zv[u].w), bfhi(zv[u].w)};
                float ss = 0.f;
#pragma unroll
                for (int j = 0; j < 8; ++j) { y[j] *= silu_f(z[j]); ss += y[j] * y[j]; }
                const float rs = rsqrtf(wave_sum(ss) * (1.0f / 512.0f) + EPS);
                const f32x4 n0 = *(const f32x4*)(nw + col), n1 = *(const f32x4*)(nw + col + 4);
                u32x4 o; o.x = cvt_pk_bf16(y[0] * rs * n0[0], y[1] * rs * n0[1]); o.y = cvt_pk_bf16(y[2] * rs * n0[2], y[3] * rs * n0[3]);
                o.z = cvt_pk_bf16(y[4] * rs * n1[0], y[5] * rs * n1[1]); o.w = cvt_pk_bf16(y[6] * rs * n1[2], y[7] * rs * n1[3]);
                *(u32x4*)(Z + (size_t)row * DIN + col) = o;
            }
        }
    }
}

constexpr int AT_K = 0, AT_KROW = 144, AT_V = 36864, AT_VROW = 144, AT_BT = 73728;
__device__ __forceinline__ void attn_bias(float (&bm)[9][4], const LAS float* bt, int ci, int q) {
#pragma unroll
    for (int jt = 0; jt < 9; ++jt)
#pragma unroll
        for (int r = 0; r < 4; ++r) { const int dist = 128 + ci - 16 * jt - 4 * q - r; const int dd = dist < 0 ? 0 : (dist > 128 ? 128 : dist); const float v = bt[dd]; bm[jt][r] = (dist >= 0 && dist <= 128) ? v : -INFINITY; }
}
__device__ __forceinline__ void attn_tile(LAS unsigned char* lds, const bf16x8 (&qf)[2], const float (&bm)[9][4], int i0, bool first, float sinkv,
                                          bf16_t* obase  , int nrows, int lane) {
    const int q = lane >> 4, c16 = lane & 15, kt0 = i0 >> 4;
    f32x4 s[9];
#pragma unroll
    for (int jt = 0; jt < 9; ++jt) {
        s[jt] = (f32x4){0.f, 0.f, 0.f, 0.f};
#pragma unroll
        for (int k = 0; k < 2; ++k) { const bf16x8 kf = *(const LAS bf16x8*)(lds + AT_K + (16 * (kt0 + jt) + c16) * AT_KROW + (32 * k + 8 * q) * 2); s[jt] = MFMA16(kf, qf[k], s[jt]); }
    }
    float mx = -INFINITY;
#pragma unroll
    for (int jt = 0; jt < 9; ++jt)
#pragma unroll
        for (int r = 0; r < 4; ++r) {
            float x = s[jt][r] * 0.125f + bm[jt][r];
            if (first) { const int j = 16 * (kt0 + jt) + 4 * q + r; x = (j >= 128) ? x : -INFINITY; }
            s[jt][r] = x; mx = fmaxf(mx, x);
        }
    mx = fmaxf(mx, __shfl_xor(mx, 16)); mx = fmaxf(mx, __shfl_xor(mx, 32)); mx = fmaxf(mx, sinkv);
    float sum = 0.f;
#pragma unroll
    for (int jt = 0; jt < 9; ++jt)
#pragma unroll
        for (int r = 0; r < 4; ++r) { const float e = __expf(s[jt][r] - mx); s[jt][r] = e; sum += e; }
    sum += __shfl_xor(sum, 16); sum += __shfl_xor(sum, 32);
    sum += __expf(sinkv - mx);
    const float inv = 1.0f / sum;
    f32x4 o[4];
#pragma unroll
    for (int dt = 0; dt < 4; ++dt) o[dt] = (f32x4){0.f, 0.f, 0.f, 0.f};
#pragma unroll
    for (int a = 0; a < 5; ++a) {
        u32x4 pw; pw.x = cvt_pk_bf16(s[2 * a][0] * inv, s[2 * a][1] * inv); pw.y = cvt_pk_bf16(s[2 * a][2] * inv, s[2 * a][3] * inv);
        if (a < 4) { pw.z = cvt_pk_bf16(s[2 * a + 1][0] * inv, s[2 * a + 1][1] * inv); pw.w = cvt_pk_bf16(s[2 * a + 1][2] * inv, s[2 * a + 1][3] * inv); } else { pw.z = 0u; pw.w = 0u; }
        const bf16x8 pa = __builtin_bit_cast(bf16x8, pw);
#pragma unroll
        for (int dt = 0; dt < 4; ++dt) {
            LAS unsigned char* vb = lds + AT_V + (16 * (kt0 + 2 * a) + 4 * q + ((lane >> 2) & 3)) * AT_VROW + (16 * dt + 4 * (lane & 3)) * 2;
            const u32x2 lo = tr_read(vb);
            u32x2 hi; hi.x = 0u; hi.y = 0u;
            if (a < 4) hi = tr_read(vb + 16 * AT_VROW);
            u32x4 vw; vw.x = lo.x; vw.y = lo.y; vw.z = hi.x; vw.w = hi.y;
            o[dt] = MFMA16(__builtin_bit_cast(bf16x8, vw), pa, o[dt]);
        }
    }
    if (c16 < nrows) {
#pragma unroll
        for (int dt = 0; dt < 4; ++dt) { u32x2 w; w.x = cvt_pk_bf16(o[dt][0], o[dt][1]); w.y = cvt_pk_bf16(o[dt][2], o[dt][3]);
            *(u32x2*)(obase + (size_t)(i0 + c16) * D + 16 * dt + 4 * q) = w; }
    }
}

__device__ __forceinline__ void attn_phase(const Ctx& c, int mode) {
    LAS unsigned char* lds = c.lds;
    const int tid = c.tid, w = c.wave;
    const bf16_t* QKV = (const bf16_t*)(c.ws + OFF_QKV); bf16_t* AO = (bf16_t*)(c.ws + OFF_AO);
    const float* rel = GIN(c, 27); const float* sinks = GIN(c, 24);
    for (int idx = tid; idx < 16 * 129; idx += 512) {
        const int h = idx / 129, d = idx % 129;
        int bk = d;
        if (d >= 16) { int lg = 16 + (int)(logf((float)d / 16.0f) / 2.0794415416798357f * 16.0f); bk = lg < 31 ? lg : 31; }
        ((LAS float*)(lds + AT_BT))[h * 132 + d] = rel[bk * 16 + h];
    }
    __syncthreads();
    for (int u = c.bid; u < (mode == 2 ? 0 : 1024); u += c.G) {
        const int b = u >> 7, qb = (u >> 2) & 31, g = u & 3;
        const size_t krow0 = (size_t)b * PSEQ + (size_t)qb * 128 - 128;
#pragma unroll
        for (int i = 0; i < 4; ++i) {
            const int idx = tid + 512 * i, j = idx >> 3, cc = idx & 7;
            u32x4 kv = (u32x4){0u, 0u, 0u, 0u}, vv = kv;
            if (qb > 0 || j >= 128) { const bf16_t* rp = QKV + (krow0 + j) * QKVD + g * 64 + cc * 8; kv = *(const u32x4*)(rp + 1024); vv = *(const u32x4*)(rp + 1280); }
            *(LAS u32x4*)(lds + AT_K + j * AT_KROW + cc * 16) = kv;
            *(LAS u32x4*)(lds + AT_V + j * AT_VROW + cc * 16) = vv;
        }
        const int hh = 4 * g + (w >> 1);
        const float sinkv = sinks[hh];
        const size_t qrow0 = (size_t)b * PSEQ + (size_t)qb * 128;
        const int lq = c.lane >> 4, lc = c.lane & 15;
        const bf16_t* qp = QKV + (qrow0 + (w & 1) * 64 + lc) * QKVD + hh * 64 + 8 * lq;
        bf16x8 qn[2];
#pragma unroll
        for (int k = 0; k < 2; ++k) qn[k] = *(const bf16x8*)(qp + 32 * k);
        float bm[9][4];
        attn_bias(bm, (const LAS float*)(lds + AT_BT) + hh * 132, lc, lq);
        __syncthreads();
#pragma unroll 1
        for (int ti = 0; ti < (mode == 3 ? 0 : 4); ++ti) {
            bf16x8 qc[2]; qc[0] = qn[0]; qc[1] = qn[1];
            if (ti + 1 < 4) {
#pragma unroll
                for (int k = 0; k < 2; ++k) qn[k] = *(const bf16x8*)(qp + (size_t)(16 * (ti + 1)) * QKVD + 32 * k);
            }
            attn_tile(lds, qc, bm, (w & 1) * 64 + 16 * ti, qb == 0, sinkv, AO + qrow0 * D + hh * 64, 16, c.lane);
        }
        __syncthreads();
    }
    const float* ck = GIN(c, 4); const float* cv = GIN(c, 5);
    for (int u = c.bid; u < ((mode == 1 || mode == 3) ? 0 : 512); u += c.G) {
        const int bs = u >> 2, g = u & 3;
        for (int idx = tid; idx < 144 * 8; idx += 512) {
            const int j = idx >> 3, cc = idx & 7;
            u32x4 kv = (u32x4){0u, 0u, 0u, 0u}, vv = kv;
            if (j < 128) {
                const float* kp = ck + (((size_t)bs * 128 + j) * 4 + g) * 64 + cc * 8; const float* vp = cv + (((size_t)bs * 128 + j) * 4 + g) * 64 + cc * 8;
                const f32x4 k0 = *(const f32x4*)kp, k1 = *(const f32x4*)(kp + 4), v0 = *(const f32x4*)vp, v1 = *(const f32x4*)(vp + 4);
                kv.x = pk2(k0[0], k0[1]); kv.y = pk2(k0[2], k0[3]); kv.z = pk2(k1[0], k1[1]); kv.w = pk2(k1[2], k1[3]);
                vv.x = pk2(v0[0], v0[1]); vv.y = pk2(v0[2], v0[3]); vv.z = pk2(v1[0], v1[1]); vv.w = pk2(v1[2], v1[3]);
            } else if (j < 136) {
                const bf16_t* rp = QKV + ((size_t)TP + (size_t)bs * 8 + (j - 128)) * QKVD + g * 64 + cc * 8; kv = *(const u32x4*)(rp + 1024); vv = *(const u32x4*)(rp + 1280);
            }
            *(LAS u32x4*)(lds + AT_K + j * AT_KROW + cc * 16) = kv;
            *(LAS u32x4*)(lds + AT_V + j * AT_VROW + cc * 16) = vv;
        }
        __syncthreads();
        if (w < 4) {
            const int hh = 4 * g + w;
            const size_t qrow0 = (size_t)TP + (size_t)bs * 8;
            const int lq = c.lane >> 4, lc = c.lane & 7;
            bf16x8 qf[2];
#pragma unroll
            for (int k = 0; k < 2; ++k) qf[k] = *(const bf16x8*)(QKV + (qrow0 + lc) * QKVD + hh * 64 + 32 * k + 8 * lq);
            float bm[9][4];
            attn_bias(bm, (const LAS float*)(lds + AT_BT) + hh * 132, lc, lq);
            attn_tile(lds, qf, bm, 0, false, sinks[hh], AO + qrow0 * D + hh * 64, 8, c.lane);
        }
        __syncthreads();
    }
    if (c.dry) return;
    const int gt = c.bid * 512 + tid, ngt = c.G * 512;
    for (int idx = gt; idx < 8 * 128 * 64; idx += ngt) {
        const int b = idx >> 13, jj = (idx >> 6) & 127, cc = (idx & 63) * 4;
        const bf16_t* rp = QKV + ((size_t)b * PSEQ + 3968 + jj) * QKVD + cc;
        const u32x2 kw = *(const u32x2*)(rp + 1024), vw = *(const u32x2*)(rp + 1280);
        *(f32x4*)(c.out + O_KP + (size_t)idx * 4) = (f32x4){bflo(kw.x), bfhi(kw.x), bflo(kw.y), bfhi(kw.y)};
        *(f32x4*)(c.out + O_VP + (size_t)idx * 4) = (f32x4){bflo(vw.x), bfhi(vw.x), bflo(vw.y), bfhi(vw.y)};
    }
    for (int idx = gt; idx < 128 * 128 * 64; idx += ngt) {
        const int b = idx >> 13, jj = (idx >> 6) & 127, cc = (idx & 63) * 4;
        f32x4 kx, vx;
        if (jj < 120) { kx = *(const f32x4*)(ck + ((size_t)b * 128 + jj + 8) * 256 + cc); vx = *(const f32x4*)(cv + ((size_t)b * 128 + jj + 8) * 256 + cc); }
        else { const bf16_t* rp = QKV + ((size_t)TP + (size_t)b * 8 + (jj - 120)) * QKVD + cc; const u32x2 kw = *(const u32x2*)(rp + 1024), vw = *(const u32x2*)(rp + 1280);
            kx = (f32x4){bflo(kw.x), bfhi(kw.x), bflo(kw.y), bfhi(kw.y)}; vx = (f32x4){bflo(vw.x), bfhi(vw.x), bflo(vw.y), bfhi(vw.y)}; }
        *(f32x4*)(c.out + O_KS + (size_t)idx * 4) = kx; *(f32x4*)(c.out + O_VS + (size_t)idx * 4) = vx;
    }
}


#define XB_TMO      128
#define XB_XCNT(j)  (256  + 64 * (j))
#define XB_XSUB(j)  (1280 + 64 * (j))
#define XB_XGEN(j)  (2304 + 64 * (j))
#define XB_TOP      3328
#define XB_TOPGEN   3392
#define XCD_BAR_WORDS 3456
#define XB_SPIN_CAP (1u << 18)
__device__ __forceinline__ unsigned xb_ld(unsigned* p)              { return __hip_atomic_load(p, __ATOMIC_RELAXED, __HIP_MEMORY_SCOPE_AGENT); }
__device__ __forceinline__ unsigned xb_add(unsigned* p, unsigned v) { return __hip_atomic_fetch_add(p, v, __ATOMIC_RELAXED, __HIP_MEMORY_SCOPE_AGENT); }
__device__ __forceinline__ unsigned xb_xcc_id() { return (unsigned)__builtin_amdgcn_s_getreg((3 << 11) | 20) & 0xFu; }
#define XB_SPIN(cond, bar) do { unsigned _sp = 0; while (cond) { __builtin_amdgcn_s_sleep(1); \
    if ((++_sp & 255u) == 0u) { if (xb_ld(&(bar)[XB_TMO])) break; if (_sp > XB_SPIN_CAP) { atomicAdd(&(bar)[XB_TMO], 1u); break; } } } } while (0)
struct XcdBarrier { unsigned* bar; unsigned x; volatile LAS unsigned* st; };
__device__ __forceinline__ XcdBarrier xcd_barrier_post(unsigned* bar, volatile LAS unsigned* st) {
    XcdBarrier b; b.bar = bar; b.x = xb_xcc_id(); b.st = st;
    if (threadIdx.x == 0) (void)xb_add(&bar[XB_XCNT(b.x)], 1u);
    return b;
}
__device__ __forceinline__ void xcd_barrier_complete(unsigned* bar, unsigned x, unsigned& nloc, unsigned& nx) {
    const unsigned G = gridDim.x * gridDim.y * gridDim.z;
    unsigned sum, cnt, mine, sp = 0u;
    for (;;) {
        sum = 0u; cnt = 0u; mine = 0u;
#pragma unroll
        for (unsigned j = 0; j < 16; ++j) { const unsigned c = xb_ld(&bar[XB_XCNT(j)]); sum += c; cnt += (c > 0u) ? 1u : 0u; mine = (j == x) ? c : mine; }
        if (sum == G) break;
        __builtin_amdgcn_s_sleep(1);
        if ((++sp & 255u) == 0u) { if (xb_ld(&bar[XB_TMO])) break; if (sp > XB_SPIN_CAP) { atomicAdd(&bar[XB_TMO], 1u); break; } }
    }
    nloc = mine > 0u ? mine : 1u; nx = cnt > 0u ? cnt : 1u;
}
__device__ __forceinline__ void xcd_barrier(const XcdBarrier& b) {
    asm volatile("s_waitcnt vmcnt(0)" ::: "memory");
    __syncthreads();
    if (threadIdx.x == 0) {
        unsigned* bar = b.bar;
        __builtin_amdgcn_s_waitcnt(0);
        unsigned nloc = b.st[0], nx = b.st[1];
        if (nloc == 0u) { xcd_barrier_complete(bar, b.x, nloc, nx); b.st[0] = nloc; b.st[1] = nx; }
        const unsigned old = xb_add(&bar[XB_XSUB(b.x)], 1u);
        const unsigned gen = old / nloc;
        if (old + 1u == (gen + 1u) * nloc) {
            __builtin_amdgcn_fence(__ATOMIC_RELEASE, "agent");
            asm volatile("s_waitcnt vmcnt(0)" ::: "memory");
            const unsigned og = xb_add(&bar[XB_TOP], 1u);
            const unsigned tg = og / nx;
            if (og + 1u == (tg + 1u) * nx) xb_add(&bar[XB_TOPGEN], 1u);
            else XB_SPIN(xb_ld(&bar[XB_TOPGEN]) == tg, bar);
            __builtin_amdgcn_fence(__ATOMIC_ACQUIRE, "agent");
            xb_add(&bar[XB_XGEN(b.x)], 1u);
            asm volatile("s_waitcnt vmcnt(0)" ::: "memory");
        } else {
            XB_SPIN(xb_ld(&bar[XB_XGEN(b.x)]) == gen, bar);
            __builtin_amdgcn_fence(__ATOMIC_ACQUIRE, "agent");
            asm volatile("s_waitcnt vmcnt(0)" ::: "memory");
        }
    }
    __syncthreads();
}


#ifndef MFMA16
#define MFMA16(a, b, c) __builtin_amdgcn_mfma_f32_16x16x32_bf16((a), (b), (c), 0, 0, 0)
#endif
template <int MODE>
__device__ __forceinline__ void small_gemm_tile(const Ctx& c, const bf16_t* A, const bf16_t* Bt, int K, int tm, int tn, bf16_t* O, int ldo, const float* bias, float* pss) {
    LAS float* P = (LAS float*)c.lds;
    const int lane = c.lane, w = c.wave, q = lane >> 4, c16 = lane & 15;
    const int kw = K >> 3, nks = kw >> 5;
    f32x4 acc[4][4];
#pragma unroll
    for (int mt = 0; mt < 4; ++mt)
#pragma unroll
        for (int nt = 0; nt < 4; ++nt) acc[mt][nt] = (f32x4){0.f, 0.f, 0.f, 0.f};
    const bf16_t* ap = A + (size_t)(64 * tm + c16) * K + w * kw + 8 * q;
    const bf16_t* bp = Bt + (size_t)(64 * tn + c16) * K + w * kw + 8 * q;
#pragma unroll 4
    for (int ks = 0; ks < nks; ++ks) {
        bf16x8 af[4], bfr[4];
#pragma unroll
        for (int mt = 0; mt < 4; ++mt) af[mt] = *(const bf16x8*)(ap + (size_t)mt * 16 * K + ks * 32);
#pragma unroll
        for (int nt = 0; nt < 4; ++nt) bfr[nt] = *(const bf16x8*)(bp + (size_t)nt * 16 * K + ks * 32);
#pragma unroll
        for (int mt = 0; mt < 4; ++mt)
#pragma unroll
            for (int nt = 0; nt < 4; ++nt) acc[mt][nt] = MFMA16(af[mt], bfr[nt], acc[mt][nt]);
    }
#pragma unroll
    for (int mt = 0; mt < 4; ++mt)
#pragma unroll
        for (int nt = 0; nt < 4; ++nt)
#pragma unroll
            for (int r = 0; r < 4; ++r) P[(w * 64 + mt * 16 + 4 * q + r) * 65 + nt * 16 + c16] = acc[mt][nt][r];
    __syncthreads();
    {
        const int row = 8 * w + (lane >> 3), col0 = (lane & 7) * 8;
        float v[8];
#pragma unroll
        for (int j = 0; j < 8; ++j) v[j] = bias ? bias[64 * tn + col0 + j] : 0.f;
#pragma unroll
        for (int ww = 0; ww < 8; ++ww)
#pragma unroll
            for (int j = 0; j < 8; ++j) v[j] += P[(ww * 64 + row) * 65 + col0 + j];
        u32x4 o; o.x = cvt_pk_bf16(v[0], v[1]); o.y = cvt_pk_bf16(v[2], v[3]); o.z = cvt_pk_bf16(v[4], v[5]); o.w = cvt_pk_bf16(v[6], v[7]);
        *(u32x4*)(O + (size_t)(64 * tm + row) * ldo + 64 * tn + col0) = o;
        if (MODE == 0) {
            float ss = 0.f;
#pragma unroll
            for (int j = 0; j < 8; ++j) ss += v[j] * v[j];
            ss += __shfl_xor(ss, 1); ss += __shfl_xor(ss, 2); ss += __shfl_xor(ss, 4);
            if ((lane & 7) == 0) pss[(size_t)(64 * tm + row) * 16 + tn] = ss;
        }
    }
    __syncthreads();
}

enum { ST_P0, ST_GMOD, ST_NORM, ST_GSWI, ST_GROWS_FFN, ST_GINPROJ, ST_CONV, ST_SCAN, ST_GATE, ST_GROWS_SSM, ST_GQKV, ST_ATTN, ST_GROWS_O, ST_NOP, ST_GSLICE };
constexpr int NREAL = 25;
#ifndef GMASK
#define GMASK 0x1FFF
#endif
#ifndef NEXTRA
#define NEXTRA 0
#endif
#ifndef EXTRA_T
#define EXTRA_T
#define EXTRA_A
#endif
constexpr int NSTEPS = NREAL + NEXTRA;
__device__ const unsigned char PROG_T[NSTEPS] = { ST_P0, ST_GMOD,
    ST_NORM, ST_GSWI, ST_GROWS_FFN, ST_NORM, ST_GINPROJ, ST_CONV, ST_SCAN, ST_GATE, ST_GROWS_SSM, ST_NORM, ST_GSWI, ST_GROWS_FFN,
    ST_NORM, ST_GSWI, ST_GROWS_FFN, ST_NORM, ST_GQKV, ST_ATTN, ST_GROWS_O, ST_NORM, ST_GSWI, ST_GROWS_FFN, ST_NORM EXTRA_T };
__device__ const unsigned char PROG_A[NSTEPS] = { 0, 0,
    0, 0, 0, 1, 0, 0, 0, 0, 0, 2, 1, 1,
    3, 2, 2, 4, 0, 0, 0, 5, 3, 3, 6 EXTRA_A };

__global__ void __launch_bounds__(512, 2) hybrid_fwd(Args args) {
    extern __shared__ __attribute__((aligned(16))) unsigned char lds_raw[];
    cg::grid_group grid = cg::this_grid();
    {
        volatile LAS unsigned* st0 = (volatile LAS unsigned*)((LAS unsigned char*)lds_raw + LDS_BYTES - 64);
        if (threadIdx.x < 2) st0[threadIdx.x] = 0u;
        __syncthreads();
    }
    const XcdBarrier xbar = xcd_barrier_post((unsigned*)(GAS unsigned*)(args.ws + OFF_CTL), (volatile LAS unsigned*)((LAS unsigned char*)lds_raw + LDS_BYTES - 64));
    for (int st = 0; st < NSTEPS; ++st) {
        int tid_o = threadIdx.x; asm volatile("" : "+v"(tid_o));
        GAS unsigned char* ws1 = (GAS unsigned char*)args.ws; asm volatile("" : "+s"(ws1));
        GAS float* out1 = (GAS float*)args.out; asm volatile("" : "+s"(out1));
        unsigned char* ws_g = (unsigned char*)ws1; float* out_g = (float*)out1;
        unsigned char* ws_f = args.ws; asm volatile("" : "+s"(ws_f));
        float* out_f = args.out; asm volatile("" : "+s"(out_f));
        unsigned char* ws = ws_f; float* outp = out_f;
#define PHSEL(bit) do { if ((GMASK >> (bit)) & 1) { c.ws = ws_g; c.out = out_g; ws = ws_g; } else { c.ws = ws_f; c.out = out_f; ws = ws_f; } } while (0)
        Ctx c;
        c.lds = (LAS unsigned char*)lds_raw;
        c.tid = tid_o; c.lane = c.tid & 63; c.wave = __builtin_amdgcn_readfirstlane(c.tid >> 6);
        c.G = gridDim.x; c.bid = blockIdx.x; c.gw = c.bid * NWAVES + c.wave; c.ngw = c.G * NWAVES;
        c.in = args.in; c.out = outp; c.ws = ws; c.dry = st >= NREAL; c.out2 = out_f; c.ws2 = ws_f;
        const int ty = PROG_T[st], arg = PROG_A[st];
        switch (ty) {
        case ST_P0: PHSEL(ST_P0); p0_phase(c); break;
        case ST_GMOD: PHSEL(ST_GMOD); {
            pg8::Gemm g{(const bf16_t*)(ws + OFF_CS), (const bf16_t*)(ws + OFF_ADAT), 256, 18432, 1024};
            pg8::StaticOrder S; S.init(256, 18432, c.G, c.bid);
            EpiMod E{(float*)(ws + OFF_MOD), ((const float*)(const GAS float*)args.in[9])};
            pg8::gemm_phase<EpiMod, pg8::StaticOrder, true, true>(c.lds, g, S, E, c.tid);
            if (c.bid >= 72) p0_run(c, 9216, 2816, 20480, 1408, 26112, 2688, (c.bid - 72) * NWAVES + c.wave, (c.G - 72) * NWAVES);
        } break;
        case ST_NORM: PHSEL(ST_NORM); norm_phase(c, arg); break;
        case ST_GSWI: PHSEL(ST_GSWI); {
            pg8::Gemm g{(const bf16_t*)(ws + OFF_HIN), (const bf16_t*)(ws + OFF_WIN) + (size_t)arg * NFF2 * D, T, NFF2, D};
            pg8::StaticOrder S; S.init(T, NFF2, c.G, c.bid);
            EpiSwiglu E{(bf16_t*)(ws + OFF_ACT)};
            pg8::gemm_phase<EpiSwiglu, pg8::StaticOrder, true, true>(c.lds, g, S, E, c.tid);
            if (arg < 3 && c.bid >= 88 && !c.dry) {
                const int vw = (c.bid - 88) * NWAVES + c.wave, nvw = (c.G - 88) * NWAVES;
                if (arg == 0) p0_run(c, 12032, 2816, 21888, 1408, 28800, 1024, vw, nvw);
                else if (arg == 1) p0_run(c, 14848, 2816, 23296, 1408, 29824, 1280, vw, nvw);
                else p0_run(c, 17664, 2816, 24704, 1408, 0, 0, vw, nvw);
            }
        } break;
        case ST_GROWS_FFN: case ST_GROWS_SSM: case ST_GROWS_O: { PHSEL(ST_GROWS_FFN);
            const bf16_t* A0; const bf16_t* B0; int K0; const float* bias = nullptr;
            if (ty == ST_GROWS_FFN) { A0 = (const bf16_t*)(ws + OFF_ACT); B0 = (const bf16_t*)(ws + OFF_WOUT) + (size_t)arg * D * DFF; K0 = DFF; }
            else if (ty == ST_GROWS_SSM) { A0 = (const bf16_t*)(ws + OFF_Z); B0 = (const bf16_t*)(ws + OFF_SSMOUT); K0 = DIN; }
            else { A0 = (const bf16_t*)(ws + OFF_AO); B0 = (const bf16_t*)(ws + OFF_OW); K0 = D; bias = ((const float*)(const GAS float*)args.in[26]); }
#pragma unroll 1
            for (int pass = 0; pass < 2; ++pass) {
                pg8::Gemm g; pg8::StaticOrder S; float* part = nullptr;
                if (pass == 0) { const int pk = c.bid >> 4;
                    g = pg8::Gemm{A0 + (size_t)TP * K0 + (size_t)pk * 256, B0 + (size_t)pk * 256, TS, D, K0, 256};
                    S.init_slices(K0 / 256, c.G, c.bid); part = (float*)(ws + OFF_PART) + (size_t)pk * TS * D; }
                else { g = pg8::Gemm{A0, B0, TP, D, K0, 0}; S.init(TP, D, c.G, c.bid); }
                EpiRows E{(bf16_t*)(ws + OFF_F), bias, (float*)(ws + OFF_PSS), part};
                pg8::gemm_phase<EpiRows, pg8::StaticOrder, true, true>(c.lds, g, S, E, c.tid);
            }
        } break;
        case ST_GINPROJ: PHSEL(ST_GINPROJ); {
            pg8::Gemm g{(const bf16_t*)(ws + OFF_HIN), (const bf16_t*)(ws + OFF_SSMIN), T, NINP, D};
            pg8::StaticOrder S; S.init(T, NINP, c.G, c.bid);
            EpiInproj E{(bf16_t*)(ws + OFF_Z), (bf16_t*)(ws + OFF_XBC), (bf16_t*)(ws + OFF_HALO), (float*)(ws + OFF_DTS), ((const float*)(const GAS float*)args.in[17])};
            pg8::gemm_phase<EpiInproj, pg8::StaticOrder, true, true>(c.lds, g, S, E, c.tid);
        } break;
        case ST_CONV: PHSEL(ST_CONV); conv_phase(c); break;
        case ST_SCAN: PHSEL(ST_SCAN); scan_phase(c, arg); break;
        case ST_GATE: PHSEL(ST_GATE); gate_phase(c); break;
        case ST_GQKV: PHSEL(ST_GQKV); {
            pg8::Gemm g{(const bf16_t*)(ws + OFF_HIN), (const bf16_t*)(ws + OFF_QKVW), TP, QKVD, D};
            for (int t = c.bid; t < 384; t += c.G)
                small_gemm_tile<1>(c, g.A + (size_t)TP * D, g.Bt, D, t / 24, t % 24, (bf16_t*)(ws + OFF_QKV) + (size_t)TP * QKVD, QKVD, ((const float*)(const GAS float*)args.in[23]), nullptr);
            pg8::StaticOrder S; S.init(TP, QKVD, c.G, c.bid);
            EpiQkv E{(bf16_t*)(ws + OFF_QKV), ((const float*)(const GAS float*)args.in[23])};
            pg8::gemm_phase<EpiQkv, pg8::StaticOrder, true, true>(c.lds, g, S, E, c.tid);
        } break;
        case ST_ATTN: PHSEL(ST_ATTN); attn_phase(c, arg); break;
        default: break;
        }
        if (st + 1 < NSTEPS) { if (st == 0) grid.sync(); else xcd_barrier(xbar); }
    }
}

extern "C" void kernel_launch(void* const* d_in, const int* in_sizes, int n_in, void* d_out, int out_size, void* d_ws, size_t ws_size, hipStream_t stream) {
    static int grid = 0;
    if (grid == 0) {
        if (n_in != 28 || ws_size < WS_NEED) { fprintf(stderr, "kernel_launch: unexpected n_in %d or ws_size %zu (need %zu)\n", n_in, ws_size, (size_t)WS_NEED); grid = -1; return; }
        int dev = 0, cus = 0, per_cu = 0;
        hipGetDevice(&dev);
        hipDeviceGetAttribute(&cus, hipDeviceAttributeMultiprocessorCount, dev);
        if (hipFuncSetAttribute((const void*)hybrid_fwd, hipFuncAttributeMaxDynamicSharedMemorySize, LDS_BYTES) != hipSuccess) { fprintf(stderr, "kernel_launch: hipFuncSetAttribute failed\n"); grid = -1; return; }
        if (hipOccupancyMaxActiveBlocksPerMultiprocessor(&per_cu, (const void*)hybrid_fwd, 512, LDS_BYTES) != hipSuccess || per_cu < 1) { fprintf(stderr, "kernel_launch: occupancy query gave %d\n", per_cu); per_cu = 1; }
        (void)hipGetLastError();
        grid = cus * (per_cu > 1 ? 1 : per_cu);
    }
    if (grid < 0) return;
    Args a{};
    for (int i = 0; i < 28; ++i) a.in[i] = (const float*)d_in[i];
    a.out = (float*)d_out; a.ws = (unsigned char*)d_ws;
    if (hipMemsetAsync((char*)d_ws + OFF_CTL, 0, CTL_BYTES, stream) != hipSuccess) { fprintf(stderr, "kernel_launch: memset failed\n"); return; }
    void* kargs[] = {&a};
    hipError_t e = hipLaunchCooperativeKernel((const void*)hybrid_fwd, dim3(grid), dim3(512), kargs, LDS_BYTES, stream);
    if (e != hipSuccess) fprintf(stderr, "kernel_launch: cooperative launch failed: %s (grid %d)\n", hipGetErrorString(e), grid);
}
```
